# Optimizing an MI355X kernel written in HIP

```python
import jax, jax.numpy as jnp
from jax import lax
import numpy as np

D_MODEL = 1024
BATCH = 2
SEQ = 8192
DEPTH = 1

CHUNK = 64
D_BRANCH = D_MODEL // 2
D_CONV = D_BRANCH
CONV_WIDTH = 3
D_RWKV = D_BRANCH
RWKV_HEAD_DIM = 64
RWKV_HEADS = D_RWKV // RWKV_HEAD_DIM
DECAY_LORA = 64
AICL_LORA = 64
GATE_LORA = 128
MEM_LEN = 256
MEM_HEADS = 4
D_MEM = D_BRANCH
MEM_HEAD_DIM = D_MEM // MEM_HEADS
N_BRANCH = 3
D_IN_PROJ = 3 * D_CONV + 3 * D_RWKV + D_MEM
N_GROUPS = 8
EXPERTS_PER_GROUP = 8
N_EXPERTS = N_GROUPS * EXPERTS_PER_GROUP
TOP_K = 2
D_EXPERT = 512
ROUTE_BLOCK = 128
NORM_EPS = 1e-6
GN_EPS = 64e-5

kernel_name = "hybrid_conv_rwkv7_memxattn_hmoe_block"


def _rmsnorm(x, g):
    xf = x.astype(jnp.float32)
    y = xf * lax.rsqrt(jnp.mean(xf * xf, axis=-1, keepdims=True) + NORM_EPS)
    return (y * g.astype(jnp.float32)).astype(x.dtype)


def _shift(u):
    return jnp.pad(u, ((0, 0), (1, 0), (0, 0)))[:, :-1]


def _split_in_proj(p):
    sizes = [D_CONV] * 3 + [D_RWKV] * 3 + [D_MEM]
    offsets = np.cumsum(sizes)[:-1].tolist()
    return jnp.split(p, offsets, axis=-1)


def _short_conv_mixer(bg, cg, u, conv_w):
    seq = u.shape[1]
    cu = cg * u
    p = jnp.pad(cu, ((0, 0), (CONV_WIDTH - 1, 0), (0, 0)))
    conv = sum(p[:, j:j + seq] * conv_w[:, j] for j in range(CONV_WIDTH))
    return bg * conv


def _rwkv7_scan(r, w, k, v, kk, a):
    b, _, h, n = r.shape

    def step(state, inp):
        r_t, w_t, k_t, v_t, kk_t, a_t = inp
        sa = jnp.einsum('bhij,bhj->bhi', state, -kk_t)
        state = (state * w_t[:, :, None, :]
                 + sa[..., None] * (kk_t * a_t)[:, :, None, :]
                 + v_t[..., None] * k_t[:, :, None, :])
        y_t = jnp.einsum('bhij,bhj->bhi', state, r_t)
        return state, y_t

    xs = tuple(jnp.moveaxis(t, 1, 0) for t in (r, w, k, v, kk, a))
    s0 = jnp.zeros((b, h, n, n), jnp.float32)
    _, ys = lax.scan(step, s0, xs)
    return jnp.moveaxis(ys, 0, 1)


def _rwkv7_mixer(h, rp, kp, vp, mu_rkv, mu_wag, w_lora1, w_lora2, w0,
                 a_lora1, a_lora2, a0, g_lora1, g_lora2, k_k, k_a, r_k,
                 ln_x_w, ln_x_b):
    b, s, _ = h.shape
    r = rp + (_shift(rp) - rp) * mu_rkv[0]
    k = kp + (_shift(kp) - kp) * mu_rkv[1]
    v = vp + (_shift(vp) - vp) * mu_rkv[2]
    dh = _shift(h) - h
    xw = h + dh * mu_wag[0]
    xa = h + dh * mu_wag[1]
    xg = h + dh * mu_wag[2]
    w_log = -jax.nn.softplus(-(w0 + jnp.tanh(xw @ w_lora1) @ w_lora2)) - 0.5
    decay = jnp.exp(-jnp.exp(w_log.astype(jnp.float32)))
    a = jax.nn.sigmoid(a0 + (xa @ a_lora1) @ a_lora2)
    g = jax.nn.sigmoid(xg @ g_lora1) @ g_lora2

    def heads(t):
        return t.reshape(b, s, RWKV_HEADS, RWKV_HEAD_DIM).astype(jnp.float32)

    kk = heads(k * k_k)
    kk = kk * lax.rsqrt(jnp.maximum(jnp.sum(kk * kk, axis=-1, keepdims=True), 1e-24))
    k = k * (1 + (a - 1) * k_a)
    rh, kh, vh, ah, wh = heads(r), heads(k), heads(v), heads(a), heads(decay)
    y = _rwkv7_scan(rh, wh, kh, vh, kk, ah)
    mu = jnp.mean(y, axis=-1, keepdims=True)
    var = jnp.mean(jnp.square(y - mu), axis=-1, keepdims=True)
    y = (y - mu) * lax.rsqrt(var + GN_EPS)
    y = (y * ln_x_w.reshape(RWKV_HEADS, RWKV_HEAD_DIM).astype(jnp.float32)
         + ln_x_b.reshape(RWKV_HEADS, RWKV_HEAD_DIM).astype(jnp.float32))
    bonus = jnp.sum(rh * kh * r_k.astype(jnp.float32), axis=-1, keepdims=True) * vh
    return (y + bonus).reshape(b, s, D_RWKV).astype(h.dtype) * g


def _memory_attention(q, mem_n, w_kv_mem):
    b, s, _ = q.shape
    kv = mem_n @ w_kv_mem
    km, vm = jnp.split(kv, 2, axis=-1)
    qh = q.reshape(b, s, MEM_HEADS, MEM_HEAD_DIM).astype(jnp.float32)
    kh = km.reshape(b, -1, MEM_HEADS, MEM_HEAD_DIM).astype(jnp.float32)
    vh = vm.reshape(b, -1, MEM_HEADS, MEM_HEAD_DIM).astype(jnp.float32)
    scores = jnp.einsum('bshd,bmhd->bhsm', qh, kh) * (MEM_HEAD_DIM ** -0.5)
    p = jax.nn.softmax(scores, axis=-1)
    o = jnp.einsum('bhsm,bmhd->bshd', p, vh)
    return o.reshape(b, s, D_MEM).astype(q.dtype)


def _hierarchical_moe(h, w_router_group, b_router_group, w_router_expert,
                      b_router_expert, w_exp_gate, w_exp_up, w_exp_down):
    b, s, d = h.shape
    t = b * s
    ht = h.reshape(t, d)
    tok = jnp.arange(t)
    gp = jax.nn.softmax((ht @ w_router_group + b_router_group).astype(jnp.float32), axis=-1)
    g_sel = jnp.argmax(gp, axis=-1)
    g_w = jnp.max(gp, axis=-1, keepdims=True)
    elog = (ht @ w_router_expert + b_router_expert).astype(jnp.float32)
    elog = elog.reshape(t, N_GROUPS, EXPERTS_PER_GROUP)[tok, g_sel]
    ep = jax.nn.softmax(elog, axis=-1)
    top_p, top_i = lax.top_k(ep, TOP_K)
    comb = (g_w * top_p / jnp.sum(top_p, axis=-1, keepdims=True)).astype(h.dtype)
    expert_idx = g_sel[:, None] * EXPERTS_PER_GROUP + top_i

    n_assign = t * TOP_K
    e_flat = expert_idx.reshape(n_assign)
    tok_flat = jnp.arange(n_assign) // TOP_K
    order = jnp.argsort(e_flat)
    e_sorted = e_flat[order]
    tok_sorted = tok_flat[order]
    counts = jnp.bincount(e_flat, length=N_EXPERTS)
    starts = jnp.cumsum(counts) - counts
    padded = ((counts + ROUTE_BLOCK - 1) // ROUTE_BLOCK) * ROUTE_BLOCK
    pad_end = jnp.cumsum(padded)
    pad_start = pad_end - padded
    dest = pad_start[e_sorted] + (jnp.arange(n_assign) - starts[e_sorted])
    n_blocks = -(-n_assign // ROUTE_BLOCK) + N_EXPERTS
    buf = jnp.zeros((n_blocks * ROUTE_BLOCK, d), h.dtype).at[dest].set(ht[tok_sorted])
    blk_start = jnp.arange(n_blocks) * ROUTE_BLOCK
    blk_expert = jnp.minimum(jnp.searchsorted(pad_end, blk_start, side='right'), N_EXPERTS - 1)

    def run_block(args):
        xb, e = args
        hid = jax.nn.silu(xb @ w_exp_gate[e]) * (xb @ w_exp_up[e])
        return hid @ w_exp_down[e]

    yb = lax.map(run_block, (buf.reshape(n_blocks, ROUTE_BLOCK, d), blk_expert))
    y_rows = yb.reshape(n_blocks * ROUTE_BLOCK, d)[dest]
    w_sorted = comb.reshape(n_assign)[order]
    out = jax.ops.segment_sum(y_rows * w_sorted[:, None], tok_sorted, num_segments=t)
    return out.reshape(b, s, d)


def _hybrid_layer(x, mem, g_mix, g_mem, w_in, conv_w, mu_rkv, mu_wag, w_lora1,
                  w_lora2, w0, a_lora1, a_lora2, a0, g_lora1, g_lora2, k_k, k_a,
                  r_k, ln_x_w, ln_x_b, w_kv_mem, w_branch, w_gate, b_gate, w_o,
                  g_ffn, w_router_group, b_router_group, w_router_expert,
                  b_router_expert, w_exp_gate, w_exp_up, w_exp_down):
    b, s, _ = x.shape
    h = _rmsnorm(x, g_mix)
    bg, cg, u, rp, kp, vp, q = _split_in_proj(h @ w_in)
    y_conv = _short_conv_mixer(bg, cg, u, conv_w)
    y_rwkv = _rwkv7_mixer(h, rp, kp, vp, mu_rkv, mu_wag, w_lora1, w_lora2, w0,
                          a_lora1, a_lora2, a0, g_lora1, g_lora2, k_k, k_a, r_k,
                          ln_x_w, ln_x_b)
    y_mem = _memory_attention(q, _rmsnorm(mem, g_mem), w_kv_mem)
    branches = jnp.stack([y_conv, y_rwkv, y_mem], axis=2)
    proj = jnp.einsum('bsnc,ncd->bsnd', branches, w_branch)
    gates = jax.nn.sigmoid(h @ w_gate + b_gate).reshape(b, s, N_BRANCH, D_MODEL)
    z = jnp.sum(gates * proj, axis=2)
    x = x + z @ w_o
    h2 = _rmsnorm(x, g_ffn)
    return x + _hierarchical_moe(h2, w_router_group, b_router_group, w_router_expert,
                                 b_router_expert, w_exp_gate, w_exp_up, w_exp_down)


def setup_inputs(seed: int = 0) -> dict:
    key = jax.random.key(seed)
    ks = iter(jax.random.split(key, 40))

    def nrm(shape, scale):
        return jax.random.normal(next(ks), shape, jnp.float32) * scale

    def uni(shape, lo, hi):
        return jax.random.uniform(next(ks), shape, jnp.float32, lo, hi)

    L = DEPTH
    return {
        "x": nrm((BATCH, SEQ, D_MODEL), 1.0),
        "mem": nrm((BATCH, MEM_LEN, D_MODEL), 1.0),
        "g_mix": 1.0 + nrm((L, D_MODEL), 0.02),
        "g_mem": 1.0 + nrm((L, D_MODEL), 0.02),
        "w_in": nrm((L, D_MODEL, D_IN_PROJ), D_MODEL ** -0.5),
        "conv_w": nrm((L, D_CONV, CONV_WIDTH), CONV_WIDTH ** -0.5),
        "mu_rkv": uni((L, 3, D_RWKV), 0.0, 1.0),
        "mu_wag": uni((L, 3, D_MODEL), 0.0, 1.0),
        "w_lora1": nrm((L, D_MODEL, DECAY_LORA), D_MODEL ** -0.5),
        "w_lora2": nrm((L, DECAY_LORA, D_RWKV), DECAY_LORA ** -0.5),
        "w0": uni((L, D_RWKV), -2.0, 1.0),
        "a_lora1": nrm((L, D_MODEL, AICL_LORA), D_MODEL ** -0.5),
        "a_lora2": nrm((L, AICL_LORA, D_RWKV), AICL_LORA ** -0.5),
        "a0": uni((L, D_RWKV), -1.0, 1.0),
        "g_lora1": nrm((L, D_MODEL, GATE_LORA), D_MODEL ** -0.5),
        "g_lora2": nrm((L, GATE_LORA, D_RWKV), GATE_LORA ** -0.5),
        "k_k": 0.85 + nrm((L, D_RWKV), 0.05),
        "k_a": 1.0 + nrm((L, D_RWKV), 0.05),
        "r_k": nrm((L, RWKV_HEADS, RWKV_HEAD_DIM), 0.1),
        "ln_x_w": 1.0 + nrm((L, D_RWKV), 0.02),
        "ln_x_b": nrm((L, D_RWKV), 0.02),
        "w_kv_mem": nrm((L, D_MODEL, 2 * D_MEM), D_MODEL ** -0.5),
        "w_branch": nrm((L, N_BRANCH, D_BRANCH, D_MODEL), D_BRANCH ** -0.5),
        "w_gate": nrm((L, D_MODEL, N_BRANCH * D_MODEL), D_MODEL ** -0.5),
        "b_gate": nrm((L, N_BRANCH * D_MODEL), 0.02),
        "w_o": nrm((L, D_MODEL, D_MODEL), D_MODEL ** -0.5),
        "g_ffn": 1.0 + nrm((L, D_MODEL), 0.02),
        "w_router_group": nrm((L, D_MODEL, N_GROUPS), D_MODEL ** -0.5),
        "b_router_group": nrm((L, N_GROUPS), 0.01),
        "w_router_expert": nrm((L, D_MODEL, N_EXPERTS), D_MODEL ** -0.5),
        "b_router_expert": nrm((L, N_EXPERTS), 0.01),
        "w_exp_gate": nrm((L, N_EXPERTS, D_MODEL, D_EXPERT), D_MODEL ** -0.5),
        "w_exp_up": nrm((L, N_EXPERTS, D_MODEL, D_EXPERT), D_MODEL ** -0.5),
        "w_exp_down": nrm((L, N_EXPERTS, D_EXPERT, D_MODEL), D_EXPERT ** -0.5),
        "g_final": 1.0 + nrm((D_MODEL,), 0.02),
    }


def reference(x, mem, g_mix, g_mem, w_in, conv_w, mu_rkv, mu_wag, w_lora1, w_lora2,
              w0, a_lora1, a_lora2, a0, g_lora1, g_lora2, k_k, k_a, r_k, ln_x_w,
              ln_x_b, w_kv_mem, w_branch, w_gate, b_gate, w_o, g_ffn,
              w_router_group, b_router_group, w_router_expert, b_router_expert,
              w_exp_gate, w_exp_up, w_exp_down, g_final):
    for l in range(DEPTH):
        x = _hybrid_layer(x, mem, g_mix[l], g_mem[l], w_in[l], conv_w[l], mu_rkv[l],
                          mu_wag[l], w_lora1[l], w_lora2[l], w0[l], a_lora1[l],
                          a_lora2[l], a0[l], g_lora1[l], g_lora2[l], k_k[l], k_a[l],
                          r_k[l], ln_x_w[l], ln_x_b[l], w_kv_mem[l], w_branch[l],
                          w_gate[l], b_gate[l], w_o[l], g_ffn[l], w_router_group[l],
                          b_router_group[l], w_router_expert[l], b_router_expert[l],
                          w_exp_gate[l], w_exp_up[l], w_exp_down[l])
    return _rmsnorm(x, g_final)
```

```cpp
#include <hip/hip_runtime.h>
#include <cstdio>
#include <cstdint>

#ifndef MK_MULTI
#define MK_MULTI 0
#endif

#define GAS __attribute__((address_space(1)))
#define LAS __attribute__((address_space(3)))
typedef unsigned short bf16;
typedef short bf16x8 __attribute__((ext_vector_type(8)));
typedef float f32x4 __attribute__((ext_vector_type(4)));
typedef float f32x16 __attribute__((ext_vector_type(16)));
typedef unsigned u32x4 __attribute__((ext_vector_type(4)));
typedef unsigned u32x2 __attribute__((ext_vector_type(2)));

constexpr int NB = 2, SEQ = 8192, T = NB * SEQ, D = 1024, DB = 512, NHEAD = 8, HD = 64;
constexpr int NINX = 4096;
constexpr int MEML = 256, NEXP = 64, DEXP = 512;
constexpr int C_BG = 0, C_CG = 512, C_U = 1024, C_RP = 1536, C_KP = 2048, C_VP = 2560, C_Q = 3072, C_LA = 3584, C_LB = 3840;
constexpr float NORM_EPS = 1e-6f, GN_EPS = 64e-5f;
constexpr int MOE_ROWS = 49152;

constexpr size_t MiB = 1u << 20;
constexpr size_t WS_CTL = 0, CTL_ZERO_BYTES = 1 * MiB;
constexpr size_t WS_WIN = 1 * MiB, WS_WGATE = 9 * MiB, WS_WBR = 15 * MiB, WS_WO = 18 * MiB, WS_WKV = 20 * MiB, WS_MISCW = 22 * MiB;
constexpr size_t WS_RTHI = WS_MISCW, WS_RTLO = WS_MISCW + 256 * 1024;
constexpr size_t WS_E1 = 24 * MiB, WS_E2 = 152 * MiB;
constexpr size_t WS_H = 216 * MiB;
constexpr size_t WS_MEMN = 248 * MiB, WS_KB = 249 * MiB, WS_VT = 249 * MiB + 512 * 1024;
constexpr size_t WS_P = 250 * MiB;
constexpr size_t WS_Z = WS_P;
constexpr size_t WS_HID = WS_P, WS_YMOE = 298 * MiB;
constexpr size_t WS_YB = 378 * MiB;
constexpr size_t WS_GS = 426 * MiB;
constexpr size_t WS_GG = 458 * MiB;
constexpr size_t WS_CB = 474 * MiB;
constexpr size_t WS_ROUTE = 475 * MiB;
constexpr size_t WS_LIST = 476 * MiB;
constexpr size_t WS_END = 480 * MiB;
constexpr size_t WS_NV = WS_E1;

constexpr int CW_BAR = 4096;
constexpr int CW_CNT = 16384;

constexpr int RING_BYTES = 131072;
constexpr int LDSCTL_OFF = RING_BYTES, MISC_OFF = LDSCTL_OFF + 320, MOE_OFF = LDSCTL_OFF + 1024;
constexpr int LDS_BYTES = 147456;

typedef GAS unsigned gu32;
#define RLX_AGENT __ATOMIC_RELAXED, __HIP_MEMORY_SCOPE_AGENT
#define LDS_WAIT() asm volatile("s_waitcnt lgkmcnt(0)" ::: "memory")
#define VM_WAIT() asm volatile("s_waitcnt vmcnt(0)" ::: "memory")
__device__ __forceinline__ unsigned f2bf(float f) { unsigned u = __builtin_bit_cast(unsigned, f); return (u + 0x7fffu + ((u >> 16) & 1u)) >> 16; }
__device__ __forceinline__ unsigned pk2(float lo, float hi) { return f2bf(lo) | (f2bf(hi) << 16); }
__device__ __forceinline__ float bf2f(unsigned b) { return __builtin_bit_cast(float, b << 16); }
__device__ __forceinline__ float bflo(unsigned w) { return __builtin_bit_cast(float, w << 16); }
__device__ __forceinline__ float bfhi(unsigned w) { return __builtin_bit_cast(float, w & 0xffff0000u); }
__device__ __forceinline__ unsigned cvt_pk_bf16(float lo, float hi) { unsigned r; asm volatile("v_cvt_pk_bf16_f32 %0, %1, %2" : "=v"(r) : "v"(lo), "v"(hi)); return r; }
__device__ __forceinline__ float wave_sum(float v) {
#pragma unroll
    for (int o = 1; o < 64; o <<= 1) v += __shfl_xor(v, o);
    return v;
}
__device__ __forceinline__ float sigmoidf_(float x) { return 1.0f / (1.0f + __expf(-x)); }

namespace pg8 {
constexpr int BM = 256, BK = 64, HALF = 128, HTB = HALF * BK * 2, STAGE_BYTES = 8 * HTB;
__host__ __device__ __forceinline__ int lds_byte(int r, int c) { const int st = (r >> 4) * 2 + (c >> 5), rr = r & 15, cc = c & 31, ob = rr * 64 + cc * 2; return st * 1024 + (ob ^ (((ob >> 9) & 1) << 5)); }
__host__ __device__ __forceinline__ void stage_rc(int b, int& R, int& C) { const int st = b / 1024, sb = b % 1024, swz = sb ^ (((sb >> 9) & 1) << 5); R = (st >> 1) * 16 + swz / 64; C = (st & 1) * 32 + (swz % 64) / 2; }
__host__ __device__ __forceinline__ int perm32(int rho) { const int n = rho >> 4, i = rho & 15; return 8 * (i >> 2) + 4 * n + (i & 3); }

struct Unit { int pm, pn, sub, nt, lda, arow0, nrows; const char* abase; const char* pb; const int* rows; };
struct LaneOff { unsigned a[2][2]; unsigned b[2]; };

__device__ __forceinline__ void tile_map(int L, int nM, int nN, int& pm, int& pn) {
    const int nwg = nM * nN; int wgid = L; { const int q = nwg / 8, r = nwg % 8, xcd = wgid % 8, off = wgid / 8; wgid = (xcd < r ? xcd * (q + 1) : r * (q + 1) + (xcd - r) * q) + off; }
    const int nig = 8 * nN, gid = wgid / nig, fm = gid * 8, gsz = (nM - fm) < 8 ? (nM - fm) : 8;
    pm = fm + ((wgid % nig) % gsz); pn = (wgid % nig) / gsz;
}

template <class Epi, class Sched, bool GATHER>
__device__ __forceinline__ void gemm_phase(LAS unsigned char* lds, const Sched& S, const Epi& E) {
    const int tid = threadIdx.x, wid = __builtin_amdgcn_readfirstlane(tid >> 6), lane = tid & 63, wr = wid >> 2, wc = wid & 3, fr = lane & 15, fq = lane >> 4;
    int R_[2], C_[2], Rb_[2];
#pragma unroll
    for (int i = 0; i < 2; ++i) { int R, C; stage_rc(tid * 16 + i * 8192, R, C); R_[i] = R; C_[i] = C; Rb_[i] = Epi::PERM ? ((R & ~31) + perm32(R & 31)) : R; }
    const unsigned ldsw = (unsigned)wid * 1024u;
    const int aoff = lds_byte(wr * 64 + fr, fq * 8), boff = lds_byte(wc * 32 + fr, fq * 8);
#define PG8_MKOFF(u, o) do { _Pragma("unroll") for (int _h = 0; _h < 2; ++_h) _Pragma("unroll") for (int _i = 0; _i < 2; ++_i) { int _row; \
        if (GATHER) { const int _idx = _h * 128 + R_[_i]; _row = _idx < (u).nrows ? (u).rows[_idx] : 0; } else _row = (u).arow0 + _h * 128 + R_[_i]; \
        (o).a[_h][_i] = (unsigned)(_row * (u).lda + C_[_i]) * 2u; } \
        _Pragma("unroll") for (int _i = 0; _i < 2; ++_i) (o).b[_i] = (unsigned)(Rb_[_i] * ((u).nt * 64) + C_[_i]) * 2u; } while (0)
#define PG8_SA(b, h) (((b) * 2 + (h)) * HTB)
#define PG8_SB(b, h) ((4 + (b) * 2 + (h)) * HTB)
#define PG8_GLDS(src, bufoff, i) __builtin_amdgcn_global_load_lds((const unsigned*)(src), (LAS unsigned*)(lds + (bufoff) + ldsw + (i) * 8192), 16, 0, 0)
#define PG8_STAGE_A(bufoff, AB, O, h, kb) do { _Pragma("unroll") for (int _i = 0; _i < 2; ++_i) PG8_GLDS((AB) + (kb) + (O).a[h][_i], bufoff, _i); } while (0)
#define PG8_STAGE_B(bufoff, BB, O, h, hs, kb) do { _Pragma("unroll") for (int _i = 0; _i < 2; ++_i) PG8_GLDS((BB) + (size_t)(h) * (hs) + (kb) + (O).b[_i], bufoff, _i); } while (0)
#define PG8_LDA(dst, b, h) do { _Pragma("unroll") for (int m = 0; m < 4; ++m) _Pragma("unroll") for (int k = 0; k < 2; ++k) dst[m][k] = *(const LAS bf16x8*)(lds + PG8_SA(b, h) + aoff + m * 2048 + k * 1024); } while (0)
#define PG8_LDB(dst, b, h) do { _Pragma("unroll") for (int n = 0; n < 2; ++n) _Pragma("unroll") for (int k = 0; k < 2; ++k) dst[n][k] = *(const LAS bf16x8*)(lds + PG8_SB(b, h) + boff + n * 2048 + k * 1024); } while (0)
#define PG8_MMA(ai, bj, At, Bt) do { __builtin_amdgcn_s_setprio(1); _Pragma("unroll") for (int m = 0; m < 4; ++m) _Pragma("unroll") for (int n = 0; n < 2; ++n) _Pragma("unroll") for (int k = 0; k < 2; ++k) \
        acc[ai][bj][m][n] = __builtin_amdgcn_mfma_f32_16x16x32_bf16(Bt[n][k], At[m][k], acc[ai][bj][m][n], 0, 0, 0); __builtin_amdgcn_s_setprio(0); } while (0)
#define PG8_WAIT_V(n) asm volatile("s_waitcnt vmcnt(" #n ")" ::: "memory")
#define PG8_WAIT_L(n) asm volatile("s_waitcnt lgkmcnt(" #n ")" ::: "memory")
#define PG8_BAR __builtin_amdgcn_s_barrier()
#define PG8_SCHED __builtin_amdgcn_sched_barrier(0)
    Unit cur, nxt; int ui = 0;
    if (!S.next(0, cur)) return;
    LaneOff co, no;
    PG8_MKOFF(cur, co);
    no = co;
    f32x4 acc[2][2][4][2];
#pragma unroll
    for (int a = 0; a < 2; ++a)
#pragma unroll
        for (int b = 0; b < 2; ++b)
#pragma unroll
            for (int m = 0; m < 4; ++m)
#pragma unroll
                for (int n = 0; n < 2; ++n) acc[a][b][m][n] = (f32x4){0.f, 0.f, 0.f, 0.f};
    bf16x8 At[4][2], B0[2][2], B1[2][2];
    const char* cA = cur.abase; const char* cB = cur.pb; size_t chs = (size_t)cur.nt * 16384;
    PG8_STAGE_B(PG8_SB(0, 0), cB, co, 0, chs, 0); PG8_STAGE_B(PG8_SB(0, 1), cB, co, 1, chs, 0); PG8_STAGE_A(PG8_SA(0, 0), cA, co, 0, 0); PG8_STAGE_A(PG8_SA(0, 1), cA, co, 1, 0);
    if (wr == 1) PG8_BAR;
    PG8_WAIT_V(2); PG8_BAR;
    PG8_STAGE_B(PG8_SB(1, 0), cB, co, 0, chs, 128); PG8_STAGE_A(PG8_SA(1, 0), cA, co, 0, 128); PG8_STAGE_B(PG8_SB(1, 1), cB, co, 1, chs, 128);
    PG8_WAIT_V(6); PG8_BAR;
    for (;;) {
        const bool has_next = S.next(ui + 1, nxt);
        if (has_next) PG8_MKOFF(nxt, no);
        const char* nA = has_next ? nxt.abase : cA; const char* nB = has_next ? nxt.pb : cB; const size_t nhs = has_next ? (size_t)nxt.nt * 16384 : chs;
        const int nt = cur.nt;
        for (int t = 0; t < nt; t += 2) {
            const bool last = (t == nt - 2);
            const unsigned kb1 = (unsigned)(t + 1) * 128u;
            const char* A2 = last ? nA : cA; const char* B2 = last ? nB : cB; const size_t hs2 = last ? nhs : chs;
            const unsigned kb2 = last ? 0u : (unsigned)(t + 2) * 128u, kb3 = kb2 + 128u;
            LaneOff o2;
#pragma unroll
            for (int h = 0; h < 2; ++h)
#pragma unroll
                for (int i = 0; i < 2; ++i) o2.a[h][i] = (last && has_next) ? no.a[h][i] : co.a[h][i];
#pragma unroll
            for (int i = 0; i < 2; ++i) o2.b[i] = (last && has_next) ? no.b[i] : co.b[i];
            PG8_LDB(B0, 0, 0); PG8_LDB(B1, 0, 1); PG8_SCHED; PG8_LDA(At, 0, 0); PG8_STAGE_A(PG8_SA(1, 1), cA, co, 1, kb1);
            PG8_WAIT_V(8); PG8_WAIT_L(0); PG8_BAR; PG8_MMA(0, 0, At, B0); PG8_MMA(0, 1, At, B1); PG8_BAR; PG8_SCHED;
            PG8_LDA(At, 0, 1); PG8_STAGE_B(PG8_SB(0, 0), B2, o2, 0, hs2, kb2); PG8_STAGE_B(PG8_SB(0, 1), B2, o2, 1, hs2, kb2); PG8_STAGE_A(PG8_SA(0, 0), A2, o2, 0, kb2);
            PG8_WAIT_V(8); PG8_WAIT_L(0); PG8_BAR; PG8_MMA(1, 0, At, B0); PG8_MMA(1, 1, At, B1); PG8_BAR; PG8_SCHED;
            PG8_LDB(B0, 1, 0); PG8_LDB(B1, 1, 1); PG8_SCHED; PG8_LDA(At, 1, 0); PG8_STAGE_A(PG8_SA(0, 1), A2, o2, 1, kb2);
            PG8_WAIT_V(8); PG8_WAIT_L(0); PG8_BAR; PG8_MMA(0, 0, At, B0); PG8_MMA(0, 1, At, B1); PG8_BAR; PG8_SCHED;
            PG8_LDA(At, 1, 1); PG8_STAGE_B(PG8_SB(1, 0), B2, o2, 0, hs2, kb3); PG8_STAGE_B(PG8_SB(1, 1), B2, o2, 1, hs2, kb3); PG8_STAGE_A(PG8_SA(1, 0), A2, o2, 0, kb3);
            PG8_WAIT_V(8); PG8_WAIT_L(0); PG8_BAR; PG8_MMA(1, 0, At, B0); PG8_MMA(1, 1, At, B1); PG8_BAR; PG8_SCHED;
        }
        if (wr == 0) PG8_BAR;
        E(acc, cur, wr, wc, fr, fq, tid);
        if (!has_next) break;
#pragma unroll
        for (int a = 0; a < 2; ++a)
#pragma unroll
            for (int b = 0; b < 2; ++b)
#pragma unroll
                for (int m = 0; m < 4; ++m)
#pragma unroll
                    for (int n = 0; n < 2; ++n) acc[a][b][m][n] = (f32x4){0.f, 0.f, 0.f, 0.f};
        cur = nxt; cA = nA; cB = nB; chs = nhs; co = no; ++ui;
        if (wr == 1) PG8_BAR;
    }
    PG8_WAIT_V(0);
    PG8_BAR;
#undef PG8_MKOFF
#undef PG8_SA
#undef PG8_SB
#undef PG8_GLDS
#undef PG8_STAGE_A
#undef PG8_STAGE_B
#undef PG8_LDA
#undef PG8_LDB
#undef PG8_MMA
#undef PG8_WAIT_V
#undef PG8_WAIT_L
#undef PG8_BAR
#undef PG8_SCHED
}

typedef const f32x4 (&AccRef)[2][2][4][2];
__device__ __forceinline__ u32x4 pack8(const f32x4 v0, const f32x4 v1) { u32x4 w; w.x = cvt_pk_bf16(v0[0], v0[1]); w.y = cvt_pk_bf16(v0[2], v0[3]); w.z = cvt_pk_bf16(v1[0], v1[1]); w.w = cvt_pk_bf16(v1[2], v1[3]); return w; }

struct EpiP {
    static constexpr bool PERM = true;
    bf16* P; bf16* KB; bf16* VT;
    __device__ __forceinline__ void operator()(AccRef acc, const Unit& u, int wr, int wc, int fr, int fq, int tid) const {
        if (u.sub == 0) {
            const int row0 = u.pm * BM + wr * 64 + fr, col0 = u.pn * BM + wc * 32 + 8 * fq;
#pragma unroll
            for (int ai = 0; ai < 2; ++ai)
#pragma unroll
                for (int m = 0; m < 4; ++m) { bf16* rowp = P + (size_t)(row0 + ai * HALF + m * 16) * NINX + col0;
#pragma unroll
                    for (int bj = 0; bj < 2; ++bj) *(u32x4*)(rowp + bj * HALF) = pack8(acc[ai][bj][m][0], acc[ai][bj][m][1]); }
        } else {
#pragma unroll
            for (int ai = 0; ai < 2; ++ai)
#pragma unroll
                for (int m = 0; m < 4; ++m) { const int row = u.pm * BM + ai * HALF + wr * 64 + m * 16 + fr;
#pragma unroll
                    for (int bj = 0; bj < 2; ++bj)
#pragma unroll
                        for (int n = 0; n < 2; ++n)
#pragma unroll
                            for (int e = 0; e < 4; ++e) { const int col = u.pn * BM + bj * HALF + wc * 32 + 8 * fq + 4 * n + e; const bf16 v = (bf16)f2bf(acc[ai][bj][m][n][e]);
                                if (col < 512) KB[(size_t)row * 512 + col] = v;
                                else { const int c2 = col - 512, hd = c2 >> 7, d = c2 & 127, b = row >> 8, key = row & 255; VT[((size_t)(b * 4 + hd) * 128 + d) * 256 + key] = v; } } }
        }
    }
};
struct EpiMerge {
    static constexpr bool PERM = true;
    const float* bgate; bf16* Gs; bf16* Z;
    __device__ __forceinline__ void operator()(AccRef acc, const Unit& u, int wr, int wc, int fr, int fq, int tid) const {
        const int br = u.sub >> 1; const int col0 = u.pn * BM + wc * 32 + 8 * fq;
        int t2 = tid; asm volatile("" : "+v"(t2));
        bf16* gsp = Gs + (size_t)(t2 >> 3) * 1024 + (t2 & 7) * 8;
        if ((u.sub & 1) == 0) {
            f32x4 bv[2][2];
#pragma unroll
            for (int bj = 0; bj < 2; ++bj)
#pragma unroll
                for (int n = 0; n < 2; ++n) bv[bj][n] = *(const f32x4*)(bgate + br * 1024 + col0 + bj * HALF + 4 * n);
#pragma unroll
            for (int ai = 0; ai < 2; ++ai)
#pragma unroll
                for (int m = 0; m < 4; ++m)
#pragma unroll
                    for (int bj = 0; bj < 2; ++bj) { f32x4 v0 = acc[ai][bj][m][0] + bv[bj][0], v1 = acc[ai][bj][m][1] + bv[bj][1];
#pragma unroll
                        for (int e = 0; e < 4; ++e) { v0[e] = sigmoidf_(v0[e]); v1[e] = sigmoidf_(v1[e]); }
                        *(u32x4*)(gsp + ((ai * 4 + m) * 2 + bj) * 64) = pack8(v0, v1); }
        } else {
            const int row0 = u.pm * BM + wr * 64 + fr;
#pragma unroll
            for (int ai = 0; ai < 2; ++ai)
#pragma unroll
                for (int m = 0; m < 4; ++m) { bf16* zrow = Z + (size_t)(row0 + ai * HALF + m * 16) * 1024 + col0;
#pragma unroll
                    for (int bj = 0; bj < 2; ++bj) { const u32x4 g = *(const u32x4*)(gsp + ((ai * 4 + m) * 2 + bj) * 64);
                        f32x4 v0 = acc[ai][bj][m][0], v1 = acc[ai][bj][m][1];
                        v0[0] *= bflo(g.x); v0[1] *= bfhi(g.x); v0[2] *= bflo(g.y); v0[3] *= bfhi(g.y); v1[0] *= bflo(g.z); v1[1] *= bfhi(g.z); v1[2] *= bflo(g.w); v1[3] *= bfhi(g.w);
                        if (br > 0) { const u32x4 z = *(const u32x4*)(zrow + bj * HALF);
                            v0[0] += bflo(z.x); v0[1] += bfhi(z.x); v0[2] += bflo(z.y); v0[3] += bfhi(z.y); v1[0] += bflo(z.z); v1[1] += bfhi(z.z); v1[2] += bflo(z.w); v1[3] += bfhi(z.w); }
                        *(u32x4*)(zrow + bj * HALF) = pack8(v0, v1); } }
        }
    }
};
struct EpiX2 {
    static constexpr bool PERM = false;
    const float* x; float* out;
    __device__ __forceinline__ void operator()(AccRef acc, const Unit& u, int wr, int wc, int fr, int fq, int tid) const {
        const int row0 = u.pm * BM + wr * 64 + fr, col0 = u.pn * BM + wc * 32 + 4 * fq;
#pragma unroll
        for (int ai = 0; ai < 2; ++ai)
#pragma unroll
            for (int m = 0; m < 4; ++m) { const size_t off = (size_t)(row0 + ai * HALF + m * 16) * 1024 + col0;
#pragma unroll
                for (int bj = 0; bj < 2; ++bj)
#pragma unroll
                    for (int n = 0; n < 2; ++n) *(f32x4*)(out + off + bj * HALF + n * 16) = *(const f32x4*)(x + off + bj * HALF + n * 16) + acc[ai][bj][m][n]; }
    }
};
struct EpiHid {
    static constexpr bool PERM = true;
    bf16* HID;
    __device__ __forceinline__ void operator()(AccRef acc, const Unit& u, int wr, int wc, int fr, int fq, int tid) const {
        const int row0 = u.pm * BM + wr * 64 + fr, col0 = u.pn * HALF + wc * 32 + 8 * fq;
#pragma unroll
        for (int ai = 0; ai < 2; ++ai)
#pragma unroll
            for (int m = 0; m < 4; ++m) { f32x4 v0, v1;
#pragma unroll
                for (int e = 0; e < 4; ++e) { const float g0 = acc[ai][0][m][0][e], g1 = acc[ai][0][m][1][e]; v0[e] = g0 * sigmoidf_(g0) * acc[ai][1][m][0][e]; v1[e] = g1 * sigmoidf_(g1) * acc[ai][1][m][1][e]; }
                *(u32x4*)(HID + (size_t)(row0 + ai * HALF + m * 16) * DEXP + col0) = pack8(v0, v1); }
    }
};
struct EpiY {
    static constexpr bool PERM = true;
    bf16* Y;
    __device__ __forceinline__ void operator()(AccRef acc, const Unit& u, int wr, int wc, int fr, int fq, int tid) const {
        const int row0 = u.pm * BM + wr * 64 + fr, col0 = u.pn * BM + wc * 32 + 8 * fq;
#pragma unroll
        for (int ai = 0; ai < 2; ++ai)
#pragma unroll
            for (int m = 0; m < 4; ++m) { bf16* rowp = Y + (size_t)(row0 + ai * HALF + m * 16) * 1024 + col0;
#pragma unroll
                for (int bj = 0; bj < 2; ++bj) *(u32x4*)(rowp + bj * HALF) = pack8(acc[ai][bj][m][0], acc[ai][bj][m][1]); }
    }
};

struct SchedP1 {
    int G, c; const char *H, *MEMN, *WIN, *WKV;
    __device__ __forceinline__ bool next(int i, Unit& u) const {
        int L = i * G + c;
        if (L < 1024) { int pm, pn; tile_map(L, 64, 16, pm, pn); u.pm = pm; u.pn = pn; u.sub = 0; u.nt = 16; u.lda = 1024; u.arow0 = pm * 256; u.nrows = 0; u.abase = H; u.pb = WIN + (size_t)pn * 256 * 2048; u.rows = nullptr; return true; }
        L -= 1024;
        if (L < 8) { const int pm = L >> 2, pn = L & 3; u.pm = pm; u.pn = pn; u.sub = 1; u.nt = 16; u.lda = 1024; u.arow0 = pm * 256; u.nrows = 0; u.abase = MEMN; u.pb = WKV + (size_t)pn * 256 * 2048; u.rows = nullptr; return true; }
        return false;
    }
};
struct SchedMerge {
    int G, c; const char *H, *YB, *WGT, *WBR;
    __device__ __forceinline__ bool next(int i, Unit& u) const {
        const int k = i / 6, sub = i - 6 * k; const int L = k * G + c; if (L >= 256) return false;
        int pm, pn; tile_map(L, 64, 4, pm, pn); const int br = sub >> 1;
        u.pm = pm; u.pn = pn; u.sub = sub; u.arow0 = pm * 256; u.nrows = 0; u.rows = nullptr;
        if ((sub & 1) == 0) { u.nt = 16; u.lda = 1024; u.abase = H; u.pb = WGT + ((size_t)(br * 1024 + pn * 256)) * 2048; }
        else { u.nt = 8; u.lda = 512; u.abase = YB + (size_t)br * T * 1024; u.pb = WBR + ((size_t)(br * 1024 + pn * 256)) * 1024; }
        return true;
    }
};
struct SchedX2 {
    int G, c; const char *Z, *WO;
    __device__ __forceinline__ bool next(int i, Unit& u) const {
        const int L = i * G + c; if (L >= 256) return false;
        int pm, pn; tile_map(L, 64, 4, pm, pn);
        u.pm = pm; u.pn = pn; u.sub = 0; u.nt = 16; u.lda = 1024; u.arow0 = pm * 256; u.nrows = 0; u.rows = nullptr; u.abase = Z; u.pb = WO + (size_t)pn * 256 * 2048; return true;
    }
};
constexpr int MOE_MAXU = 8;
struct SchedMoe {
    const volatile LAS int* tab; int phase;
    const char *H2, *HID, *W1, *W2; const int* LIST;
    __device__ __forceinline__ bool next(int i, Unit& u) const {
        if (i >= MOE_MAXU) return false;
        const int e = tab[136 + 4 * i]; if (e < 0) return false;
        const int gt = tab[136 + 4 * i + 1], pn = tab[136 + 4 * i + 2], rt = tab[136 + 4 * i + 3];
        u.pm = gt; u.pn = pn; u.sub = e;
        if (phase == 1) { u.nt = 16; u.lda = 1024; u.arow0 = 0; u.abase = H2; u.rows = LIST + (size_t)e * T + rt * 256; const int c = tab[e] - rt * 256; u.nrows = c < 256 ? c : 256; u.pb = W1 + ((size_t)e * 1024 + pn * 256) * 2048; }
        else { u.nt = 8; u.lda = 512; u.arow0 = gt * 256; u.abase = HID; u.rows = nullptr; u.nrows = 0; u.pb = W2 + ((size_t)e * 1024 + pn * 256) * 1024; }
        return true;
    }
};
}

#define XB_TMO      128
#define XB_XCNT(j)  (256  + 64 * (j))
#define XB_XSUB(j)  (1280 + 64 * (j))
#define XB_XGEN(j)  (2304 + 64 * (j))
#define XB_TOP      3328
#define XB_TOPGEN   3392
#define XCD_BAR_WORDS 3456
#define XB_SPIN_CAP (1u << 18)
__device__ __forceinline__ unsigned xb_ld(unsigned* p)              { return __hip_atomic_load(p, __ATOMIC_RELAXED, __HIP_MEMORY_SCOPE_AGENT); }
__device__ __forceinline__ unsigned xb_add(unsigned* p, unsigned v) { return __hip_atomic_fetch_add(p, v, __ATOMIC_RELAXED, __HIP_MEMORY_SCOPE_AGENT); }
__device__ __forceinline__ unsigned xb_xcc_id() { return (unsigned)__builtin_amdgcn_s_getreg((3 << 11) | 20) & 0xFu; }
#define XB_SPIN(cond, bar) do { unsigned _sp = 0; while (cond) { __builtin_amdgcn_s_sleep(1); \
    if ((++_sp & 255u) == 0u) { if (xb_ld(&(bar)[XB_TMO])) break; if (_sp > XB_SPIN_CAP) { atomicAdd(&(bar)[XB_TMO], 1u); break; } } } } while (0)
struct XcdBarrier { unsigned* bar; unsigned x; volatile LAS unsigned* st; };
__device__ __forceinline__ XcdBarrier xcd_barrier_post(unsigned* bar, volatile LAS unsigned* st) {
    XcdBarrier b; b.bar = bar; b.x = xb_xcc_id(); b.st = st;
    if (threadIdx.x == 0) (void)xb_add(&bar[XB_XCNT(b.x)], 1u);
    return b;
}
__device__ __forceinline__ void xcd_barrier_complete(unsigned* bar, unsigned x, unsigned& nloc, unsigned& nx) {
    const unsigned G = gridDim.x * gridDim.y * gridDim.z;
    unsigned sum, cnt, mine, sp = 0u;
    for (;;) {
        sum = 0u; cnt = 0u; mine = 0u;
#pragma unroll
        for (unsigned j = 0; j < 16; ++j) { const unsigned c = xb_ld(&bar[XB_XCNT(j)]); sum += c; cnt += (c > 0u) ? 1u : 0u; mine = (j == x) ? c : mine; }
        if (sum == G) break;
        __builtin_amdgcn_s_sleep(1);
        if ((++sp & 255u) == 0u) { if (xb_ld(&bar[XB_TMO])) break; if (sp > XB_SPIN_CAP) { atomicAdd(&bar[XB_TMO], 1u); break; } }
    }
    nloc = mine > 0u ? mine : 1u; nx = cnt > 0u ? cnt : 1u;
}
__device__ __forceinline__ void xcd_barrier(const XcdBarrier& b) {
    asm volatile("s_waitcnt vmcnt(0)" ::: "memory");
    __syncthreads();
    if (threadIdx.x == 0) {
        unsigned* bar = b.bar;
        __builtin_amdgcn_s_waitcnt(0);
        unsigned nloc = b.st[0], nx = b.st[1];
        if (nloc == 0u) { xcd_barrier_complete(bar, b.x, nloc, nx); b.st[0] = nloc; b.st[1] = nx; }
        const unsigned old = xb_add(&bar[XB_XSUB(b.x)], 1u);
        const unsigned gen = old / nloc;
        if (old + 1u == (gen + 1u) * nloc) {
            __builtin_amdgcn_fence(__ATOMIC_RELEASE, "agent");
            asm volatile("s_waitcnt vmcnt(0)" ::: "memory");
            const unsigned og = xb_add(&bar[XB_TOP], 1u);
            const unsigned tg = og / nx;
            if (og + 1u == (tg + 1u) * nx) xb_add(&bar[XB_TOPGEN], 1u);
            else XB_SPIN(xb_ld(&bar[XB_TOPGEN]) == tg, bar);
            __builtin_amdgcn_fence(__ATOMIC_ACQUIRE, "agent");
            xb_add(&bar[XB_XGEN(b.x)], 1u);
            asm volatile("s_waitcnt vmcnt(0)" ::: "memory");
        } else {
            XB_SPIN(xb_ld(&bar[XB_XGEN(b.x)]) == gen, bar);
            __builtin_amdgcn_fence(__ATOMIC_ACQUIRE, "agent");
            asm volatile("s_waitcnt vmcnt(0)" ::: "memory");
        }
    }
    __syncthreads();
}

constexpr int NWAVES = 8;
struct Args { const float* in[35]; float* out; unsigned char* ws; int ph_lo, ph_hi; };
struct Frame {
    LAS unsigned char* lds;
    volatile LAS unsigned* MISC;
    gu32* ctl;
    int tid, lane, wave, vcu, G;
    float* out; unsigned char* ws;
};

__device__ __forceinline__ void transpose_item(const float* W, int ldw, int K, int k0, int n0, bf16* WT, int drow0, const float* sc, int mode, LAS float* scr, int lane) {
#pragma unroll 8
    for (int i = 0; i < 32; ++i) { const int kk = 2 * i + (lane >> 5); float v = W[(size_t)(k0 + kk) * ldw + n0 + (lane & 31)];
        if (mode) { const float s = sc[k0 + kk]; v *= (mode == 1) ? s : (1.0f - s); }
        scr[kk * 33 + (lane & 31)] = v; }
    LDS_WAIT(); asm volatile("" ::: "memory");
    const int c = lane & 7;
#pragma unroll
    for (int j = 0; j < 4; ++j) { const int n = (lane >> 3) + 8 * j; const LAS float* s = scr + (8 * c) * 33 + n;
        u32x4 o; o.x = pk2(s[0 * 33], s[1 * 33]); o.y = pk2(s[2 * 33], s[3 * 33]); o.z = pk2(s[4 * 33], s[5 * 33]); o.w = pk2(s[6 * 33], s[7 * 33]);
        *(GAS u32x4*)(WT + (size_t)(drow0 + n) * K + k0 + 8 * c) = o; }
    LDS_WAIT(); asm volatile("" ::: "memory");
}
__device__ __forceinline__ void rms_row_to_bf16(const float* xrow, const float* g, bf16* orow, int lane) {
    const GAS f32x4* xr = (const GAS f32x4*)xrow + lane; const GAS f32x4* gr = (const GAS f32x4*)g + lane;
    f32x4 v[4]; float s = 0.f;
#pragma unroll
    for (int j = 0; j < 4; ++j) { v[j] = xr[64 * j]; s += (v[j].x * v[j].x + v[j].y * v[j].y) + (v[j].z * v[j].z + v[j].w * v[j].w); }
    const float rinv = 1.0f / sqrtf(wave_sum(s) * (1.f / D) + NORM_EPS);
    GAS unsigned long long* o8 = (GAS unsigned long long*)orow + lane;
#pragma unroll
    for (int j = 0; j < 4; ++j) { const f32x4 gv = gr[64 * j]; const f32x4 o = v[j] * rinv * gv; o8[64 * j] = (unsigned long long)pk2(o.x, o.y) | ((unsigned long long)pk2(o.z, o.w) << 32); }
}

__device__ __forceinline__ void p0_prologue(Frame& F, const Args& A) {
    LAS float* scr = (LAS float*)(F.lds + F.wave * 16384);
    const int gw = F.vcu * NWAVES + F.wave, NGW = F.G * NWAVES;
    bf16* WIN = (bf16*)(F.ws + WS_WIN); bf16* WGT = (bf16*)(F.ws + WS_WGATE); bf16* WBR = (bf16*)(F.ws + WS_WBR); bf16* WO = (bf16*)(F.ws + WS_WO); bf16* WKV = (bf16*)(F.ws + WS_WKV);
    constexpr int I_IN = 16 * 112, I_LO = 16 * 8, I_G = 16 * 96, I_BR = 8 * 32, I_O = 16 * 32, I_KV = 16 * 32;
    constexpr int NITEMS = I_IN + 2 * I_LO + I_G + 3 * I_BR + I_O + I_KV;
    for (int it = gw; it < NITEMS; it += NGW) {
        int r = it;
        if (r < I_IN) { const int kb = r / 112, nb = r % 112; transpose_item(A.in[4], 3584, 1024, 64 * kb, 32 * nb, WIN, 32 * nb, nullptr, 0, scr, F.lane); continue; } r -= I_IN;
        if (r < 2 * I_LO) { const int part = r / I_LO; r -= part * I_LO; const int kb = r / 8, nb = r % 8;
            const int n = 32 * nb; const float* W; int ldw, nn, mu;
            if (n < 64) { W = A.in[8]; ldw = 64; nn = n; mu = 0; } else if (n < 128) { W = A.in[11]; ldw = 64; nn = n - 64; mu = 1; } else { W = A.in[14]; ldw = 128; nn = n - 128; mu = 2; }
            transpose_item(W, ldw, 1024, 64 * kb, nn, WIN, (part == 0 ? C_LA : C_LB) + n, A.in[7] + mu * 1024, part == 0 ? 2 : 1, scr, F.lane); continue; } r -= 2 * I_LO;
        if (r < I_G) { const int kb = r / 96, nb = r % 96; transpose_item(A.in[23], 3072, 1024, 64 * kb, 32 * nb, WGT, 32 * nb, nullptr, 0, scr, F.lane); continue; } r -= I_G;
        if (r < 3 * I_BR) { const int br = r / I_BR; r -= br * I_BR; const int kb = r / 32, nb = r % 32; transpose_item(A.in[22] + (size_t)br * 512 * 1024, 1024, 512, 64 * kb, 32 * nb, WBR + (size_t)br * 1024 * 512, 32 * nb, nullptr, 0, scr, F.lane); continue; } r -= 3 * I_BR;
        if (r < I_O) { const int kb = r / 32, nb = r % 32; transpose_item(A.in[25], 1024, 1024, 64 * kb, 32 * nb, WO, 32 * nb, nullptr, 0, scr, F.lane); continue; } r -= I_O;
        { const int kb = r / 32, nb = r % 32; transpose_item(A.in[21], 1024, 1024, 64 * kb, 32 * nb, WKV, 32 * nb, nullptr, 0, scr, F.lane); }
    }
    { bf16* RH = (bf16*)(F.ws + WS_RTHI); bf16* RL = (bf16*)(F.ws + WS_RTLO);
      for (int idx = (F.vcu * NWAVES + F.wave) * 64 + F.lane; idx < 80 * 1024; idx += NGW * 64) { const int n = idx >> 10, k = idx & 1023;
          float w = 0.f; if (n < 8) w = A.in[27][k * 8 + n]; else if (n < 72) w = A.in[29][k * 64 + (n - 8)];
          const unsigned hi = f2bf(w); const float lo = w - bf2f(hi); RH[idx] = (bf16)hi; RL[idx] = (bf16)f2bf(lo); } }
    bf16* H = (bf16*)(F.ws + WS_H); bf16* MEMN = (bf16*)(F.ws + WS_MEMN);
    for (int m = gw; m < T; m += NGW) rms_row_to_bf16(A.in[0] + (size_t)m * D, A.in[2], H + (size_t)m * D, F.lane);
    for (int m = gw; m < NB * MEML; m += NGW) rms_row_to_bf16(A.in[1] + (size_t)m * D, A.in[3], MEMN + (size_t)m * D, F.lane);
}

__device__ __forceinline__ void convert_experts(Frame& F, const Args& A, int gw, int NGW) {
    LAS float* scr = (LAS float*)(F.lds + F.wave * 16384);
    bf16* E1 = (bf16*)(F.ws + WS_E1); bf16* E2 = (bf16*)(F.ws + WS_E2);
    constexpr int PER_E = 256;
    for (int it = gw; it < 3 * NEXP * PER_E; it += NGW) {
        const int mat = it / (NEXP * PER_E); int r = it - mat * (NEXP * PER_E); const int e = r / PER_E; r -= e * PER_E;
        if (mat < 2) { const int kb = r / 16, nb = r % 16, n = 32 * nb;
            transpose_item(A.in[31 + mat] + (size_t)e * 1024 * 512, 512, 1024, 64 * kb, n, E1 + (size_t)e * 1024 * 1024, (n >> 7) * 256 + mat * 128 + (n & 127), nullptr, 0, scr, F.lane); }
        else { const int kb = r / 32, nb = r % 32;
            transpose_item(A.in[33] + (size_t)e * 512 * 1024, 1024, 512, 64 * kb, 32 * nb, E2 + (size_t)e * 1024 * 512, 32 * nb, nullptr, 0, scr, F.lane); }
    }
}

__device__ __forceinline__ void mem_attn_unit(Frame& F, int unit) {
    const bf16* P = (const bf16*)(F.ws + WS_P); const bf16* KB = (const bf16*)(F.ws + WS_KB); const bf16* VT = (const bf16*)(F.ws + WS_VT); bf16* Y = (bf16*)(F.ws + WS_YB) + (size_t)2 * T * DB;
    const int b = unit >> 7, hd = (unit >> 5) & 3, qb = unit & 31;
    const int t0 = b * SEQ + qb * 256 + F.wave * 32, rr = F.lane & 31, h = F.lane >> 5;
    bf16x8 qf[8];
    { const bf16* qrow = P + (size_t)(t0 + rr) * NINX + C_Q + hd * 128 + 8 * h;
#pragma unroll
      for (int ks = 0; ks < 8; ++ks) qf[ks] = *(const GAS bf16x8*)(qrow + 16 * ks); }
    f32x16 s[8];
    const bf16* kbase = KB + (size_t)(b * 256 + rr) * 512 + hd * 128 + 8 * h;
#pragma unroll
    for (int kt = 0; kt < 8; ++kt) { f32x16 a = {0.f, 0.f, 0.f, 0.f, 0.f, 0.f, 0.f, 0.f, 0.f, 0.f, 0.f, 0.f, 0.f, 0.f, 0.f, 0.f};
#pragma unroll
        for (int ks = 0; ks < 8; ++ks) { const bf16x8 kf = *(const GAS bf16x8*)(kbase + (size_t)kt * 32 * 512 + 16 * ks); a = __builtin_amdgcn_mfma_f32_32x32x16_bf16(kf, qf[ks], a, 0, 0, 0); }
        s[kt] = a; }
    float mx = -3.0e38f;
#pragma unroll
    for (int kt = 0; kt < 8; ++kt)
#pragma unroll
        for (int r = 0; r < 16; ++r) mx = fmaxf(mx, s[kt][r]);
    mx = fmaxf(mx, __shfl_xor(mx, 32));
    const float sc = 0.08838834764831845f * 1.4426950408889634f; float sum = 0.f;
#pragma unroll
    for (int kt = 0; kt < 8; ++kt)
#pragma unroll
        for (int r = 0; r < 16; ++r) { const float p = exp2f((s[kt][r] - mx) * sc); s[kt][r] = p; sum += p; }
    sum += __shfl_xor(sum, 32);
    const float inv = 1.0f / sum;
    f32x16 o[4];
#pragma unroll
    for (int dt = 0; dt < 4; ++dt) o[dt] = (f32x16){0.f, 0.f, 0.f, 0.f, 0.f, 0.f, 0.f, 0.f, 0.f, 0.f, 0.f, 0.f, 0.f, 0.f, 0.f, 0.f};
    const bf16* vbase = VT + ((size_t)(b * 4 + hd) * 128 + rr) * 256 + 4 * h;
#pragma unroll
    for (int kt = 0; kt < 8; ++kt)
#pragma unroll
        for (int sp = 0; sp < 2; ++sp) {
            u32x4 pw; pw.x = cvt_pk_bf16(s[kt][8 * sp + 0], s[kt][8 * sp + 1]); pw.y = cvt_pk_bf16(s[kt][8 * sp + 2], s[kt][8 * sp + 3]); pw.z = cvt_pk_bf16(s[kt][8 * sp + 4], s[kt][8 * sp + 5]); pw.w = cvt_pk_bf16(s[kt][8 * sp + 6], s[kt][8 * sp + 7]);
            const bf16x8 pb = __builtin_bit_cast(bf16x8, pw);
#pragma unroll
            for (int dt = 0; dt < 4; ++dt) { const bf16* vp = vbase + (size_t)dt * 32 * 256 + 32 * kt + 16 * sp;
                const u32x2 lo = *(const GAS u32x2*)(vp), hi = *(const GAS u32x2*)(vp + 8);
                const u32x4 vw = {lo.x, lo.y, hi.x, hi.y};
                o[dt] = __builtin_amdgcn_mfma_f32_32x32x16_bf16(__builtin_bit_cast(bf16x8, vw), pb, o[dt], 0, 0, 0); } }
    bf16* yrow = Y + (size_t)(t0 + rr) * DB + hd * 128 + 4 * h;
#pragma unroll
    for (int dt = 0; dt < 4; ++dt)
#pragma unroll
        for (int g = 0; g < 4; ++g) { u32x2 w; w.x = cvt_pk_bf16(o[dt][4 * g] * inv, o[dt][4 * g + 1] * inv); w.y = cvt_pk_bf16(o[dt][4 * g + 2] * inv, o[dt][4 * g + 3] * inv);
            *(GAS u32x2*)(yrow + 32 * dt + 8 * g) = w; }
}

__device__ __forceinline__ void conv_job(Frame& F, const Args& A, int job) {
    const bf16* P = (const bf16*)(F.ws + WS_P); bf16* Y = (bf16*)(F.ws + WS_YB);
    const int c = F.tid, t0 = job * 64;
    const float w0 = A.in[5][c * 3 + 0], w1 = A.in[5][c * 3 + 1], w2 = A.in[5][c * 3 + 2];
    float cu1 = 0.f, cu2 = 0.f;
    if ((t0 & (SEQ - 1)) != 0) { const bf16* p1 = P + (size_t)(t0 - 1) * NINX; const bf16* p2 = P + (size_t)(t0 - 2) * NINX; cu1 = bf2f(p1[C_CG + c]) * bf2f(p1[C_U + c]); cu2 = bf2f(p2[C_CG + c]) * bf2f(p2[C_U + c]); }
#pragma unroll 4
    for (int t = t0; t < t0 + 64; ++t) { const bf16* p = P + (size_t)t * NINX; const float bg = bf2f(p[C_BG + c]), cu = bf2f(p[C_CG + c]) * bf2f(p[C_U + c]);
        Y[(size_t)t * DB + c] = (bf16)f2bf(bg * (w0 * cu2 + w1 * cu1 + w2 * cu)); cu2 = cu1; cu1 = cu; }
}

__device__ __forceinline__ void rwkv_prep_naive(Frame& F, const Args& A, int job) {
    const bf16* P = (const bf16*)(F.ws + WS_P);
    float* NW = (float*)(F.ws + WS_NV); float* NKK = NW + (size_t)T * DB; float* NBB = NKK + (size_t)T * DB; float* NKM = NBB + (size_t)T * DB; float* NVV = NKM + (size_t)T * DB; float* NR = NVV + (size_t)T * DB;
    bf16* GG = (bf16*)(F.ws + WS_GG); float* CB = (float*)(F.ws + WS_CB);
    LAS float* act = (LAS float*)F.lds;
    const int c = F.tid, hd = c >> 6;
    const float mu_r = A.in[6][c], mu_k = A.in[6][512 + c], mu_v = A.in[6][1024 + c];
    const float w0c = A.in[10][c], a0c = A.in[13][c], kkc = A.in[16][c], kac = A.in[17][c], rkc = A.in[18][c];
    for (int blk = 0; blk < 8; ++blk) {
        const int tb = job * 64 + blk * 8;
        if (c < 256) {
#pragma unroll
            for (int tk = 0; tk < 8; ++tk) { const int t = tb + tk; float v = bf2f(P[(size_t)t * NINX + C_LA + c]); if ((t & (SEQ - 1)) != 0) v += bf2f(P[(size_t)(t - 1) * NINX + C_LB + c]);
                if (c < 64) v = tanhf(v); else if (c >= 128) v = sigmoidf_(v);
                act[c * 8 + tk] = v; }
        }
        __syncthreads();
        float dw[8], da[8], dg[8];
#pragma unroll
        for (int k = 0; k < 8; ++k) { dw[k] = 0.f; da[k] = 0.f; dg[k] = 0.f; }
        for (int n = 0; n < 64; ++n) { const float wv = A.in[9][n * 512 + c], av = A.in[12][n * 512 + c];
            const f32x4 x0 = *(const LAS f32x4*)(act + n * 8), x1 = *(const LAS f32x4*)(act + n * 8 + 4), y0 = *(const LAS f32x4*)(act + (64 + n) * 8), y1 = *(const LAS f32x4*)(act + (64 + n) * 8 + 4);
#pragma unroll
            for (int k = 0; k < 4; ++k) { dw[k] += x0[k] * wv; dw[4 + k] += x1[k] * wv; da[k] += y0[k] * av; da[4 + k] += y1[k] * av; } }
        for (int n = 0; n < 128; ++n) { const float gv = A.in[15][n * 512 + c];
            const f32x4 x0 = *(const LAS f32x4*)(act + (128 + n) * 8), x1 = *(const LAS f32x4*)(act + (128 + n) * 8 + 4);
#pragma unroll
            for (int k = 0; k < 4; ++k) { dg[k] += x0[k] * gv; dg[4 + k] += x1[k] * gv; } }
        float rp_p = 0.f, kp_p = 0.f, vp_p = 0.f;
        if ((tb & (SEQ - 1)) != 0) { const bf16* pp = P + (size_t)(tb - 1) * NINX; rp_p = bf2f(pp[C_RP + c]); kp_p = bf2f(pp[C_KP + c]); vp_p = bf2f(pp[C_VP + c]); }
#pragma unroll
        for (int tk = 0; tk < 8; ++tk) { const int t = tb + tk; const bf16* p = P + (size_t)t * NINX;
            const float rp = bf2f(p[C_RP + c]), kp = bf2f(p[C_KP + c]), vp = bf2f(p[C_VP + c]);
            const float r = rp + (rp_p - rp) * mu_r, k = kp + (kp_p - kp) * mu_k, v = vp + (vp_p - vp) * mu_v;
            rp_p = rp; kp_p = kp; vp_p = vp;
            const float xw = -(w0c + dw[tk]); const float sp = fmaxf(xw, 0.f) + log1pf(__expf(-fabsf(xw)));
            const float wl = -sp - 0.5f; const float decay = __expf(-__expf(wl));
            const float a = sigmoidf_(a0c + da[tk]);
            const float kkv = k * kkc; const float n2 = wave_sum(kkv * kkv); const float kk = kkv * (1.0f / sqrtf(fmaxf(n2, 1e-24f)));
            const float km = k * (1.f + (a - 1.f) * kac);
            const float cb = wave_sum(r * km * rkc);
            const size_t o = (size_t)t * DB + c;
            NW[o] = decay; NKK[o] = kk; NBB[o] = kk * a; NKM[o] = km; NVV[o] = v; NR[o] = r; GG[o] = (bf16)f2bf(dg[tk]);
            if (F.lane == 0) CB[(size_t)t * 8 + hd] = cb; }
        __syncthreads();
    }
}
__device__ __forceinline__ void rwkv_scan_naive(Frame& F, const Args& A, int chain) {
    const float* NW = (const float*)(F.ws + WS_NV); const float* NKK = NW + (size_t)T * DB; const float* NBB = NKK + (size_t)T * DB; const float* NKM = NBB + (size_t)T * DB; const float* NVV = NKM + (size_t)T * DB; const float* NR = NVV + (size_t)T * DB;
    const bf16* GG = (const bf16*)(F.ws + WS_GG); const float* CB = (const float*)(F.ws + WS_CB); bf16* Y = (bf16*)(F.ws + WS_YB) + (size_t)T * DB;
    if (F.wave != 0) return;
    LAS float* blk = (LAS float*)F.lds;
    const int b = chain >> 3, hd = chain & 7, lane = F.lane, ch = hd * 64 + lane;
    const float lnw = A.in[19][ch], lnb = A.in[20][ch];
    float s[64];
#pragma unroll
    for (int j = 0; j < 64; ++j) s[j] = 0.f;
    for (int t0 = b * SEQ; t0 < (b + 1) * SEQ; t0 += 16) {
#pragma unroll
        for (int tk = 0; tk < 16; ++tk) { const size_t o = (size_t)(t0 + tk) * DB + ch;
            blk[(tk * 5 + 0) * 64 + lane] = NW[o]; blk[(tk * 5 + 1) * 64 + lane] = NKK[o]; blk[(tk * 5 + 2) * 64 + lane] = NBB[o]; blk[(tk * 5 + 3) * 64 + lane] = NKM[o]; blk[(tk * 5 + 4) * 64 + lane] = NR[o]; }
        LDS_WAIT(); asm volatile("" ::: "memory");
        for (int tk = 0; tk < 16; ++tk) { const int t = t0 + tk; const size_t o = (size_t)t * DB + ch;
            const float v = NVV[o];
            const LAS f32x4* wv = (const LAS f32x4*)(blk + (tk * 5 + 0) * 64); const LAS f32x4* kv = (const LAS f32x4*)(blk + (tk * 5 + 1) * 64); const LAS f32x4* bv = (const LAS f32x4*)(blk + (tk * 5 + 2) * 64);
            const LAS f32x4* mv = (const LAS f32x4*)(blk + (tk * 5 + 3) * 64); const LAS f32x4* rv = (const LAS f32x4*)(blk + (tk * 5 + 4) * 64);
            float sa = 0.f;
#pragma unroll
            for (int j = 0; j < 16; ++j) { const f32x4 k4 = kv[j]; sa += s[4 * j] * k4[0] + s[4 * j + 1] * k4[1] + s[4 * j + 2] * k4[2] + s[4 * j + 3] * k4[3]; }
            sa = -sa; float y = 0.f;
#pragma unroll
            for (int j = 0; j < 16; ++j) { const f32x4 w4 = wv[j], b4 = bv[j], m4 = mv[j], r4 = rv[j];
#pragma unroll
                for (int e = 0; e < 4; ++e) { const float ns = s[4 * j + e] * w4[e] + sa * b4[e] + v * m4[e]; s[4 * j + e] = ns; y += ns * r4[e]; } }
            const float mu = wave_sum(y) * (1.f / 64.f); const float dlt = y - mu; const float var = wave_sum(dlt * dlt) * (1.f / 64.f);
            const float yn = dlt * (1.0f / sqrtf(var + GN_EPS)) * lnw + lnb;
            const float outv = (yn + CB[(size_t)t * 8 + hd] * v) * bf2f(GG[o]);
            Y[o] = (bf16)f2bf(outv); }
        LDS_WAIT(); asm volatile("" ::: "memory");
    }
}

__device__ __forceinline__ void router_job(Frame& F, const Args& A, int job) {
    const float* X2 = F.out; bf16* H2 = (bf16*)(F.ws + WS_H); const bf16* RH = (const bf16*)(F.ws + WS_RTHI); const bf16* RL = (const bf16*)(F.ws + WS_RTLO);
    int* ROUTE = (int*)(F.ws + WS_ROUTE); float* COMB = (float*)(F.ws + WS_ROUTE + 512 * 1024); int* LIST = (int*)(F.ws + WS_LIST); unsigned* CNT = (unsigned*)(F.ctl + CW_CNT);
    LAS float* lg = (LAS float*)(F.lds + F.wave * 8192);
    const int lane = F.lane, row = lane & 15, q = lane >> 4, tb = job * 16;
    const float* xr = X2 + (size_t)(tb + row) * D + 8 * q;
    float ss = 0.f;
#pragma unroll 8
    for (int ks = 0; ks < 32; ++ks) { const f32x4 a = *(const GAS f32x4*)(xr + 32 * ks), b = *(const GAS f32x4*)(xr + 32 * ks + 4); ss += (a.x * a.x + a.y * a.y) + (a.z * a.z + a.w * a.w) + (b.x * b.x + b.y * b.y) + (b.z * b.z + b.w * b.w); }
    ss += __shfl_xor(ss, 16); ss += __shfl_xor(ss, 32);
    const float rinv = 1.0f / sqrtf(ss * (1.f / D) + NORM_EPS);
    f32x4 acc[5];
#pragma unroll
    for (int nt = 0; nt < 5; ++nt) acc[nt] = (f32x4){0.f, 0.f, 0.f, 0.f};
    const float* gf = A.in[26] + 8 * q;
#pragma unroll 2
    for (int ks = 0; ks < 32; ++ks) {
        const f32x4 a = *(const GAS f32x4*)(xr + 32 * ks), b = *(const GAS f32x4*)(xr + 32 * ks + 4); const f32x4 ga = *(const GAS f32x4*)(gf + 32 * ks), gb = *(const GAS f32x4*)(gf + 32 * ks + 4);
        float hv[8]; hv[0] = a.x * rinv * ga.x; hv[1] = a.y * rinv * ga.y; hv[2] = a.z * rinv * ga.z; hv[3] = a.w * rinv * ga.w; hv[4] = b.x * rinv * gb.x; hv[5] = b.y * rinv * gb.y; hv[6] = b.z * rinv * gb.z; hv[7] = b.w * rinv * gb.w;
        unsigned hi[8], lo[8];
#pragma unroll
        for (int e = 0; e < 8; ++e) { hi[e] = f2bf(hv[e]); lo[e] = f2bf(hv[e] - bf2f(hi[e])); }
        const u32x4 hw = {hi[0] | (hi[1] << 16), hi[2] | (hi[3] << 16), hi[4] | (hi[5] << 16), hi[6] | (hi[7] << 16)};
        const u32x4 lw = {lo[0] | (lo[1] << 16), lo[2] | (lo[3] << 16), lo[4] | (lo[5] << 16), lo[6] | (lo[7] << 16)};
        *(GAS u32x4*)(H2 + (size_t)(tb + row) * D + 32 * ks + 8 * q) = hw;
        const bf16x8 ah = __builtin_bit_cast(bf16x8, hw), al = __builtin_bit_cast(bf16x8, lw);
#pragma unroll
        for (int nt = 0; nt < 5; ++nt) { const size_t wo = (size_t)(16 * nt + row) * 1024 + 32 * ks + 8 * q;
            const bf16x8 bh = *(const GAS bf16x8*)(RH + wo), bl = *(const GAS bf16x8*)(RL + wo);
            acc[nt] = __builtin_amdgcn_mfma_f32_16x16x32_bf16(ah, bh, acc[nt], 0, 0, 0);
            acc[nt] = __builtin_amdgcn_mfma_f32_16x16x32_bf16(al, bh, acc[nt], 0, 0, 0);
            acc[nt] = __builtin_amdgcn_mfma_f32_16x16x32_bf16(ah, bl, acc[nt], 0, 0, 0); }
    }
#pragma unroll
    for (int nt = 0; nt < 5; ++nt)
#pragma unroll
        for (int r = 0; r < 4; ++r) lg[(4 * q + r) * 80 + 16 * nt + row] = acc[nt][r];
    LDS_WAIT(); asm volatile("" ::: "memory");
    if (lane < 16) { const int t = tb + lane; const LAS float* l = lg + lane * 80;
        float gl[8]; int gs = 0; float gm = -3.0e38f;
#pragma unroll
        for (int i = 0; i < 8; ++i) { gl[i] = l[i] + A.in[28][i]; if (gl[i] > gm) { gm = gl[i]; gs = i; } }
        float gsum = 0.f;
#pragma unroll
        for (int i = 0; i < 8; ++i) gsum += __expf(gl[i] - gm);
        const float gw = 1.0f / gsum;
        float e0v = -3.0e38f, e1v = -3.0e38f; int i0 = 0, i1 = 0;
#pragma unroll
        for (int i = 0; i < 8; ++i) { const float v = l[8 + gs * 8 + i] + A.in[30][gs * 8 + i];
            if (v > e0v) { e1v = e0v; i1 = i0; e0v = v; i0 = i; } else if (v > e1v) { e1v = v; i1 = i; } }
        const float x = __expf(e1v - e0v); const float c0 = gw / (1.f + x), c1 = gw * x / (1.f + x);
        const int e0 = gs * 8 + i0, e1 = gs * 8 + i1;
        const int p0 = (int)__hip_atomic_fetch_add(CNT + e0, 1u, RLX_AGENT), p1 = (int)__hip_atomic_fetch_add(CNT + e1, 1u, RLX_AGENT);
        LIST[(size_t)e0 * T + p0] = t; LIST[(size_t)e1 * T + p1] = t;
        ROUTE[4 * t + 0] = e0; ROUTE[4 * t + 1] = p0; ROUTE[4 * t + 2] = e1; ROUTE[4 * t + 3] = p1; COMB[2 * t] = c0; COMB[2 * t + 1] = c1; }
    LDS_WAIT(); asm volatile("" ::: "memory");
}

__device__ __forceinline__ void moe_build_table(Frame& F) {
    volatile LAS int* tab = (volatile LAS int*)(F.lds + MOE_OFF);
    if (F.tid < NEXP) tab[F.tid] = (int)__hip_atomic_load((unsigned*)(F.ctl + CW_CNT) + F.tid, RLX_AGENT);
    __syncthreads();
    if (F.tid == 0) { int run = 0;
        for (int e = 0; e < NEXP; ++e) { tab[64 + e] = run; run += (tab[e] + 255) >> 8; }
        tab[128] = run; tab[129] = run;
        const int U = run * 4; int e = 0;
        for (int i = 0; i < pg8::MOE_MAXU; ++i) { const int L = i * F.G + (int)blockIdx.x;
            if (L < U) { const int q = U / 8, r = U % 8, xcd = L % 8, off = L / 8; const int id = (xcd < r ? xcd * (q + 1) : r * (q + 1) + (xcd - r) * q) + off;
                const int gt = id >> 2, pn = id & 3; e = 0; while (e < NEXP - 1 && tab[64 + e + 1] <= gt) ++e;
                tab[136 + 4 * i] = e; tab[136 + 4 * i + 1] = gt; tab[136 + 4 * i + 2] = pn; tab[136 + 4 * i + 3] = gt - tab[64 + e]; }
            else tab[136 + 4 * i] = -1; } }
    __syncthreads();
}
__device__ __forceinline__ void final_rows(Frame& F, const Args& A, int gw, int NGW) {
    volatile LAS int* tab = (volatile LAS int*)(F.lds + MOE_OFF);
    const int* ROUTE = (const int*)(F.ws + WS_ROUTE); const float* COMB = (const float*)(F.ws + WS_ROUTE + 512 * 1024); const bf16* YM = (const bf16*)(F.ws + WS_YMOE);
    for (int t = gw; t < T; t += NGW) {
        const int e0 = ROUTE[4 * t], p0 = ROUTE[4 * t + 1], e1 = ROUTE[4 * t + 2], p1 = ROUTE[4 * t + 3]; const float c0 = COMB[2 * t], c1 = COMB[2 * t + 1];
        const size_t r0 = (size_t)tab[64 + e0] * 256 + p0, r1 = (size_t)tab[64 + e1] * 256 + p1;
        GAS f32x4* xr = (GAS f32x4*)(F.out + (size_t)t * D) + F.lane; const GAS u32x2* y0 = (const GAS u32x2*)(YM + r0 * D) + F.lane; const GAS u32x2* y1 = (const GAS u32x2*)(YM + r1 * D) + F.lane;
        f32x4 v[4]; float s = 0.f;
#pragma unroll
        for (int j = 0; j < 4; ++j) { v[j] = xr[64 * j]; const u32x2 a = y0[64 * j], b = y1[64 * j];
            v[j].x += c0 * bflo(a.x) + c1 * bflo(b.x); v[j].y += c0 * bfhi(a.x) + c1 * bfhi(b.x); v[j].z += c0 * bflo(a.y) + c1 * bflo(b.y); v[j].w += c0 * bfhi(a.y) + c1 * bfhi(b.y);
            s += (v[j].x * v[j].x + v[j].y * v[j].y) + (v[j].z * v[j].z + v[j].w * v[j].w); }
        const float rinv = 1.0f / sqrtf(wave_sum(s) * (1.f / D) + NORM_EPS);
        const GAS f32x4* gr = (const GAS f32x4*)A.in[34] + F.lane;
#pragma unroll
        for (int j = 0; j < 4; ++j) xr[64 * j] = v[j] * rinv * gr[64 * j];
    }
}

constexpr int N_PHASES = 11;
__global__ void __launch_bounds__(NWAVES * 64, 2) mk_fwd(Args args) {
    extern __shared__ __attribute__((aligned(16))) unsigned char lds[];
    Frame F;
    F.lds = (LAS unsigned char*)lds;
    F.MISC = (volatile LAS unsigned*)(F.lds + MISC_OFF);
    F.tid = threadIdx.x; F.lane = F.tid & 63; F.wave = __builtin_amdgcn_readfirstlane(F.tid >> 6);
    F.G = gridDim.x; { const int bx = blockIdx.x; F.vcu = (F.G % 8 == 0) ? (bx % 8) * (F.G / 8) + bx / 8 : bx; }
    unsigned char* ws = args.ws; F.ws = ws; F.out = args.out;
    F.ctl = (gu32*)(ws + WS_CTL);
    for (int u = F.tid; u < (LDS_BYTES - LDSCTL_OFF) / 4; u += NWAVES * 64) ((LAS unsigned*)(F.lds + LDSCTL_OFF))[u] = 0u;
    __syncthreads();
#if MK_MULTI
#define GRID_BAR() do { } while (0)
#else
    XcdBarrier bar = xcd_barrier_post((unsigned*)(F.ctl + CW_BAR), F.MISC + 8);
#define GRID_BAR() xcd_barrier(bar)
#endif
    const int lo = args.ph_lo, hi = args.ph_hi;
#define IN(k) (lo <= (k) && (k) < hi)
#define BOTH(k) (IN(k) && IN((k) + 1))
    const int gw = F.vcu * NWAVES + F.wave, NGW = F.G * NWAVES;
    const char* wsc = (const char*)ws;

    if (IN(0)) { p0_prologue(F, args); if (BOTH(0)) GRID_BAR(); }
    if (IN(1)) {
        pg8::SchedP1 S{F.G, (int)blockIdx.x, wsc + WS_H, wsc + WS_MEMN, wsc + WS_WIN, wsc + WS_WKV};
        pg8::EpiP E{(bf16*)(ws + WS_P), (bf16*)(ws + WS_KB), (bf16*)(ws + WS_VT)};
        pg8::gemm_phase<pg8::EpiP, pg8::SchedP1, false>(F.lds, S, E);
        if (BOTH(1)) GRID_BAR();
    }
    if (IN(2)) {
        for (int j = blockIdx.x; j < T / 64; j += F.G) { rwkv_prep_naive(F, args, j); conv_job(F, args, j); }
        for (int u = blockIdx.x; u < 256; u += F.G) mem_attn_unit(F, u);
        if (BOTH(2)) GRID_BAR();
    }
    if (IN(3)) {
        for (int ch = blockIdx.x; ch < NB * NHEAD; ch += F.G) rwkv_scan_naive(F, args, ch);
        if (BOTH(3)) GRID_BAR();
    }
    if (IN(4)) { convert_experts(F, args, gw, NGW); if (BOTH(4)) GRID_BAR(); }
    if (IN(5)) {
        pg8::SchedMerge S{F.G, (int)blockIdx.x, wsc + WS_H, wsc + WS_YB, wsc + WS_WGATE, wsc + WS_WBR};
        pg8::EpiMerge E{args.in[24], (bf16*)(ws + WS_GS) + (size_t)blockIdx.x * 65536, (bf16*)(ws + WS_Z)};
        pg8::gemm_phase<pg8::EpiMerge, pg8::SchedMerge, false>(F.lds, S, E);
        if (BOTH(5)) GRID_BAR();
    }
    if (IN(6)) {
        pg8::SchedX2 S{F.G, (int)blockIdx.x, wsc + WS_Z, wsc + WS_WO};
        pg8::EpiX2 E{args.in[0], F.out};
        pg8::gemm_phase<pg8::EpiX2, pg8::SchedX2, false>(F.lds, S, E);
        if (BOTH(6)) GRID_BAR();
    }
    if (IN(7)) { for (int j = gw; j < T / 16; j += NGW) router_job(F, args, j); if (BOTH(7)) GRID_BAR(); }
    if (IN(8)) {
        moe_build_table(F);
        pg8::SchedMoe S{(const volatile LAS int*)(F.lds + MOE_OFF), 1, wsc + WS_H, wsc + WS_HID, wsc + WS_E1, wsc + WS_E2, (const int*)(ws + WS_LIST)};
        pg8::EpiHid E{(bf16*)(ws + WS_HID)};
        pg8::gemm_phase<pg8::EpiHid, pg8::SchedMoe, true>(F.lds, S, E);
        if (BOTH(8)) GRID_BAR();
    }
    if (IN(9)) {
        moe_build_table(F);
        pg8::SchedMoe S{(const volatile LAS int*)(F.lds + MOE_OFF), 2, wsc + WS_H, wsc + WS_HID, wsc + WS_E1, wsc + WS_E2, (const int*)(ws + WS_LIST)};
        pg8::EpiY E{(bf16*)(ws + WS_YMOE)};
        pg8::gemm_phase<pg8::EpiY, pg8::SchedMoe, false>(F.lds, S, E);
        if (BOTH(9)) GRID_BAR();
    }
    if (IN(10)) { moe_build_table(F); final_rows(F, args, gw, NGW); }
#undef IN
#undef BOTH
}

extern "C" void kernel_launch(void* const* d_in, const int* in_sizes, int n_in, void* d_out, int out_size, void* d_ws, size_t ws_size, hipStream_t stream) {
    static int grid = 0;
    if (grid == 0) {
        if (n_in != 35 || in_sizes[0] != T * D || out_size != T * D || ws_size < WS_END) { fprintf(stderr, "kernel_launch: unexpected shapes / workspace (n_in %d, in0 %d, out %d, ws %zu)\n", n_in, n_in > 0 ? in_sizes[0] : -1, out_size, ws_size); grid = -1; return; }
        int dev = 0, cus = 0, per_cu = 0;
        if (hipGetDevice(&dev) != hipSuccess || hipDeviceGetAttribute(&cus, hipDeviceAttributeMultiprocessorCount, dev) != hipSuccess) { grid = -1; return; }
        if (hipFuncSetAttribute((const void*)mk_fwd, hipFuncAttributeMaxDynamicSharedMemorySize, LDS_BYTES) != hipSuccess) { fprintf(stderr, "kernel_launch: hipFuncSetAttribute failed\n"); grid = -1; return; }
        if (hipOccupancyMaxActiveBlocksPerMultiprocessor(&per_cu, (const void*)mk_fwd, NWAVES * 64, LDS_BYTES) != hipSuccess || per_cu < 1) fprintf(stderr, "kernel_launch: occupancy query reports %d\n", per_cu);
        (void)hipGetLastError();
        grid = cus;
    }
    if (grid < 0) return;
    if (hipMemsetAsync((char*)d_ws + WS_CTL, 0, CTL_ZERO_BYTES, stream) != hipSuccess) { fprintf(stderr, "kernel_launch: memset failed\n"); return; }
    Args a{};
    for (int i = 0; i < 35; ++i) a.in[i] = (const float*)d_in[i];
    a.out = (float*)d_out; a.ws = (unsigned char*)d_ws;
#if MK_MULTI
    for (int p = 0; p < N_PHASES; ++p) { a.ph_lo = p; a.ph_hi = p + 1; hipLaunchKernelGGL(mk_fwd, dim3(grid), dim3(NWAVES * 64), LDS_BYTES, stream, a); }
#else
    a.ph_lo = 0; a.ph_hi = N_PHASES; hipLaunchKernelGGL(mk_fwd, dim3(grid), dim3(NWAVES * 64), LDS_BYTES, stream, a);
#endif
    const hipError_t le = hipPeekAtLastError();
    if (le != hipSuccess) fprintf(stderr, "kernel_launch: launch failed: %s\n", hipGetErrorName(le));
}
```

```cpp
#include <hip/hip_runtime.h>
#include <cstdio>
#include <cstdint>

#ifndef MK_MULTI
#define MK_MULTI 0
#endif

#define GAS __attribute__((address_space(1)))
#define LAS __attribute__((address_space(3)))
typedef unsigned short bf16;
typedef short bf16x8 __attribute__((ext_vector_type(8)));
typedef float f32x4 __attribute__((ext_vector_type(4)));
typedef float f32x16 __attribute__((ext_vector_type(16)));
typedef unsigned u32x4 __attribute__((ext_vector_type(4)));
typedef unsigned u32x2 __attribute__((ext_vector_type(2)));

constexpr int NB = 2, SEQ = 8192, T = NB * SEQ, D = 1024, DB = 512, NHEAD = 8, HD = 64;
constexpr int NINX = 4096;
constexpr int MEML = 256, NEXP = 64, DEXP = 512;
constexpr int C_BG = 0, C_CG = 512, C_U = 1024, C_RP = 1536, C_KP = 2048, C_VP = 2560, C_Q = 3072, C_LA = 3584, C_LB = 3840;
constexpr float NORM_EPS = 1e-6f, GN_EPS = 64e-5f;
constexpr int MOE_ROWS = 49152;

constexpr size_t MiB = 1u << 20;
constexpr size_t WS_CTL = 0, CTL_ZERO_BYTES = 1 * MiB;
constexpr size_t WS_WIN = 1 * MiB, WS_WGATE = 9 * MiB, WS_WBR = 15 * MiB, WS_WO = 18 * MiB, WS_WKV = 20 * MiB, WS_MISCW = 22 * MiB;
constexpr size_t WS_RTHI = WS_MISCW, WS_RTLO = WS_MISCW + 256 * 1024;
constexpr size_t WS_W2T = WS_MISCW + 512 * 1024, WS_A2T = WS_MISCW + 576 * 1024, WS_G2T = WS_MISCW + 640 * 1024;
constexpr size_t WS_E1 = 24 * MiB, WS_E2 = 152 * MiB;
constexpr size_t WS_H = 216 * MiB;
constexpr size_t WS_MEMN = 248 * MiB, WS_KB = 249 * MiB, WS_VT = 249 * MiB + 512 * 1024;
constexpr size_t WS_P = 250 * MiB;
constexpr size_t WS_Z = WS_P;
constexpr size_t WS_HID = WS_P, WS_YMOE = 298 * MiB;
constexpr size_t WS_YB = 378 * MiB;
constexpr size_t WS_GS = 426 * MiB;
constexpr size_t WS_GG = 458 * MiB;
constexpr size_t WS_CB = 474 * MiB;
constexpr size_t WS_GC = 474 * MiB + 512 * 1024;
constexpr size_t WS_S2 = WS_E1;
constexpr size_t WS_BD = WS_GS;
constexpr size_t OUT_BG = 0, OUT_BQ1 = 16 * MiB, OUT_BYL = 32 * MiB, OUT_BS = 48 * MiB;
constexpr size_t WS_ROUTE = 475 * MiB;
constexpr size_t WS_LIST = 476 * MiB;
constexpr size_t WS_END = 480 * MiB;
constexpr size_t WS_NV = WS_E1;

constexpr int CW_BAR = 4096;
constexpr int CW_CNT = 16384;

constexpr int RING_BYTES = 131072;
constexpr int LDSCTL_OFF = 139264, MISC_OFF = LDSCTL_OFF + 320, MOE_OFF = LDSCTL_OFF + 1024;
constexpr int LDS_BYTES = 147456;

typedef GAS unsigned gu32;
#define RLX_AGENT __ATOMIC_RELAXED, __HIP_MEMORY_SCOPE_AGENT
#define LDS_WAIT() asm volatile("s_waitcnt lgkmcnt(0)" ::: "memory")
#define VM_WAIT() asm volatile("s_waitcnt vmcnt(0)" ::: "memory")
__device__ __forceinline__ unsigned f2bf(float f) { unsigned u = __builtin_bit_cast(unsigned, f); return (u + 0x7fffu + ((u >> 16) & 1u)) >> 16; }
__device__ __forceinline__ unsigned pk2(float lo, float hi) { return f2bf(lo) | (f2bf(hi) << 16); }
__device__ __forceinline__ float bf2f(unsigned b) { return __builtin_bit_cast(float, b << 16); }
__device__ __forceinline__ float bflo(unsigned w) { return __builtin_bit_cast(float, w << 16); }
__device__ __forceinline__ float bfhi(unsigned w) { return __builtin_bit_cast(float, w & 0xffff0000u); }
__device__ __forceinline__ unsigned cvt_pk_bf16(float lo, float hi) { unsigned r; asm volatile("v_cvt_pk_bf16_f32 %0, %1, %2" : "=v"(r) : "v"(lo), "v"(hi)); return r; }
__device__ __forceinline__ float wave_sum(float v) {
#pragma unroll
    for (int o = 1; o < 64; o <<= 1) v += __shfl_xor(v, o);
    return v;
}
__device__ __forceinline__ float dpp_add(float v, float src_from) { return v + src_from; }
#define DPPF(v, ctrl, rmask) __builtin_bit_cast(float, __builtin_amdgcn_update_dpp(0, __builtin_bit_cast(int, (v)), (ctrl), (rmask), 0xF, false))
__device__ __forceinline__ float wave_sum_dpp(float v) {
    v += DPPF(v, 0xB1, 0xF); v += DPPF(v, 0x4E, 0xF); v += DPPF(v, 0x141, 0xF); v += DPPF(v, 0x140, 0xF);
    v += DPPF(v, 0x142, 0xA); v += DPPF(v, 0x143, 0xC);
    return __builtin_bit_cast(float, __builtin_amdgcn_readlane(__builtin_bit_cast(int, v), 63));
}
__device__ __forceinline__ float sigmoidf_(float x) { return 1.0f / (1.0f + __expf(-x)); }

namespace pg8 {
constexpr int BM = 256, BK = 64, HALF = 128, HTB = HALF * BK * 2, STAGE_BYTES = 8 * HTB;
__host__ __device__ __forceinline__ int lds_byte(int r, int c) { const int st = (r >> 4) * 2 + (c >> 5), rr = r & 15, cc = c & 31, ob = rr * 64 + cc * 2; return st * 1024 + (ob ^ (((ob >> 9) & 1) << 5)); }
__host__ __device__ __forceinline__ void stage_rc(int b, int& R, int& C) { const int st = b / 1024, sb = b % 1024, swz = sb ^ (((sb >> 9) & 1) << 5); R = (st >> 1) * 16 + swz / 64; C = (st & 1) * 32 + (swz % 64) / 2; }
__host__ __device__ __forceinline__ int perm32(int rho) { const int n = rho >> 4, i = rho & 15; return 8 * (i >> 2) + 4 * n + (i & 3); }

struct Unit { int pm, pn, sub, nt, lda, arow0, nrows; const char* abase; const char* pb; const int* rows; };
struct LaneOff { unsigned a[2][2]; unsigned b[2]; };

__device__ __forceinline__ void tile_map(int L, int nM, int nN, int& pm, int& pn) {
    const int nwg = nM * nN; int wgid = L; { const int q = nwg / 8, r = nwg % 8, xcd = wgid % 8, off = wgid / 8; wgid = (xcd < r ? xcd * (q + 1) : r * (q + 1) + (xcd - r) * q) + off; }
    const int nig = 8 * nN, gid = wgid / nig, fm = gid * 8, gsz = (nM - fm) < 8 ? (nM - fm) : 8;
    pm = fm + ((wgid % nig) % gsz); pn = (wgid % nig) / gsz;
}

template <class Epi, class Sched, bool GATHER>
__device__ __forceinline__ void gemm_phase(LAS unsigned char* lds, const Sched& S, const Epi& E) {
    const int tid = threadIdx.x, wid = __builtin_amdgcn_readfirstlane(tid >> 6), lane = tid & 63, wr = wid >> 2, wc = wid & 3, fr = lane & 15, fq = lane >> 4;
    int R_[2], C_[2], Rb_[2];
#pragma unroll
    for (int i = 0; i < 2; ++i) { int R, C; stage_rc(tid * 16 + i * 8192, R, C); R_[i] = R; C_[i] = C; Rb_[i] = Epi::PERM ? ((R & ~31) + perm32(R & 31)) : R; }
    const unsigned ldsw = (unsigned)wid * 1024u;
    const int aoff = lds_byte(wr * 64 + fr, fq * 8), boff = lds_byte(wc * 32 + fr, fq * 8);
#define PG8_MKOFF(u, o) do { _Pragma("unroll") for (int _h = 0; _h < 2; ++_h) _Pragma("unroll") for (int _i = 0; _i < 2; ++_i) { int _row; \
        if (GATHER) { const int _idx = _h * 128 + R_[_i]; _row = _idx < (u).nrows ? (u).rows[_idx] : 0; } else _row = (u).arow0 + _h * 128 + R_[_i]; \
        (o).a[_h][_i] = (unsigned)(_row * (u).lda + C_[_i]) * 2u; } \
        _Pragma("unroll") for (int _i = 0; _i < 2; ++_i) (o).b[_i] = (unsigned)(Rb_[_i] * ((u).nt * 64) + C_[_i]) * 2u; } while (0)
#define PG8_SA(b, h) (((b) * 2 + (h)) * HTB)
#define PG8_SB(b, h) ((4 + (b) * 2 + (h)) * HTB)
#define PG8_GLDS(src, bufoff, i) __builtin_amdgcn_global_load_lds((const unsigned*)(src), (LAS unsigned*)(lds + (bufoff) + ldsw + (i) * 8192), 16, 0, 0)
#define PG8_STAGE_A(bufoff, AB, O, h, kb) do { _Pragma("unroll") for (int _i = 0; _i < 2; ++_i) PG8_GLDS((AB) + (kb) + (O).a[h][_i], bufoff, _i); } while (0)
#define PG8_STAGE_B(bufoff, BB, O, h, hs, kb) do { _Pragma("unroll") for (int _i = 0; _i < 2; ++_i) PG8_GLDS((BB) + (size_t)(h) * (hs) + (kb) + (O).b[_i], bufoff, _i); } while (0)
#define PG8_LDA(dst, b, h) do { _Pragma("unroll") for (int m = 0; m < 4; ++m) _Pragma("unroll") for (int k = 0; k < 2; ++k) dst[m][k] = *(const LAS bf16x8*)(lds + PG8_SA(b, h) + aoff + m * 2048 + k * 1024); } while (0)
#define PG8_LDB(dst, b, h) do { _Pragma("unroll") for (int n = 0; n < 2; ++n) _Pragma("unroll") for (int k = 0; k < 2; ++k) dst[n][k] = *(const LAS bf16x8*)(lds + PG8_SB(b, h) + boff + n * 2048 + k * 1024); } while (0)
#define PG8_MMA(ai, bj, At, Bt) do { __builtin_amdgcn_s_setprio(1); _Pragma("unroll") for (int m = 0; m < 4; ++m) _Pragma("unroll") for (int n = 0; n < 2; ++n) _Pragma("unroll") for (int k = 0; k < 2; ++k) \
        acc[ai][bj][m][n] = __builtin_amdgcn_mfma_f32_16x16x32_bf16(Bt[n][k], At[m][k], acc[ai][bj][m][n], 0, 0, 0); __builtin_amdgcn_s_setprio(0); } while (0)
#define PG8_WAIT_V(n) asm volatile("s_waitcnt vmcnt(" #n ")" ::: "memory")
#define PG8_WAIT_L(n) asm volatile("s_waitcnt lgkmcnt(" #n ")" ::: "memory")
#define PG8_BAR __builtin_amdgcn_s_barrier()
#define PG8_SCHED __builtin_amdgcn_sched_barrier(0)
    Unit cur, nxt; int ui = 0;
    if (!S.next(0, cur)) return;
    LaneOff co, no;
    PG8_MKOFF(cur, co);
    no = co;
    f32x4 acc[2][2][4][2];
#pragma unroll
    for (int a = 0; a < 2; ++a)
#pragma unroll
        for (int b = 0; b < 2; ++b)
#pragma unroll
            for (int m = 0; m < 4; ++m)
#pragma unroll
                for (int n = 0; n < 2; ++n) acc[a][b][m][n] = (f32x4){0.f, 0.f, 0.f, 0.f};
    bf16x8 At[4][2], B0[2][2], B1[2][2];
    const char* cA = cur.abase; const char* cB = cur.pb; size_t chs = (size_t)cur.nt * 16384;
    PG8_STAGE_B(PG8_SB(0, 0), cB, co, 0, chs, 0); PG8_STAGE_B(PG8_SB(0, 1), cB, co, 1, chs, 0); PG8_STAGE_A(PG8_SA(0, 0), cA, co, 0, 0); PG8_STAGE_A(PG8_SA(0, 1), cA, co, 1, 0);
    if (wr == 1) PG8_BAR;
    PG8_WAIT_V(2); PG8_BAR;
    PG8_STAGE_B(PG8_SB(1, 0), cB, co, 0, chs, 128); PG8_STAGE_A(PG8_SA(1, 0), cA, co, 0, 128); PG8_STAGE_B(PG8_SB(1, 1), cB, co, 1, chs, 128);
    PG8_WAIT_V(6); PG8_BAR;
    for (;;) {
        const bool has_next = S.next(ui + 1, nxt);
        if (has_next) PG8_MKOFF(nxt, no);
        const char* nA = has_next ? nxt.abase : cA; const char* nB = has_next ? nxt.pb : cB; const size_t nhs = has_next ? (size_t)nxt.nt * 16384 : chs;
        const int nt = cur.nt;
        for (int t = 0; t < nt; t += 2) {
            const bool last = (t == nt - 2);
            const unsigned kb1 = (unsigned)(t + 1) * 128u;
            const char* A2 = last ? nA : cA; const char* B2 = last ? nB : cB; const size_t hs2 = last ? nhs : chs;
            const unsigned kb2 = last ? 0u : (unsigned)(t + 2) * 128u, kb3 = kb2 + 128u;
            LaneOff o2;
#pragma unroll
            for (int h = 0; h < 2; ++h)
#pragma unroll
                for (int i = 0; i < 2; ++i) o2.a[h][i] = (last && has_next) ? no.a[h][i] : co.a[h][i];
#pragma unroll
            for (int i = 0; i < 2; ++i) o2.b[i] = (last && has_next) ? no.b[i] : co.b[i];
            PG8_LDB(B0, 0, 0); PG8_LDB(B1, 0, 1); PG8_SCHED; PG8_LDA(At, 0, 0); PG8_STAGE_A(PG8_SA(1, 1), cA, co, 1, kb1);
            PG8_WAIT_V(8); PG8_WAIT_L(0); PG8_BAR; PG8_MMA(0, 0, At, B0); PG8_MMA(0, 1, At, B1); PG8_BAR; PG8_SCHED;
            PG8_LDA(At, 0, 1); PG8_STAGE_B(PG8_SB(0, 0), B2, o2, 0, hs2, kb2); PG8_STAGE_B(PG8_SB(0, 1), B2, o2, 1, hs2, kb2); PG8_STAGE_A(PG8_SA(0, 0), A2, o2, 0, kb2);
            PG8_WAIT_V(8); PG8_WAIT_L(0); PG8_BAR; PG8_MMA(1, 0, At, B0); PG8_MMA(1, 1, At, B1); PG8_BAR; PG8_SCHED;
            PG8_LDB(B0, 1, 0); PG8_LDB(B1, 1, 1); PG8_SCHED; PG8_LDA(At, 1, 0); PG8_STAGE_A(PG8_SA(0, 1), A2, o2, 1, kb2);
            PG8_WAIT_V(8); PG8_WAIT_L(0); PG8_BAR; PG8_MMA(0, 0, At, B0); PG8_MMA(0, 1, At, B1); PG8_BAR; PG8_SCHED;
            PG8_LDA(At, 1, 1); PG8_STAGE_B(PG8_SB(1, 0), B2, o2, 0, hs2, kb3); PG8_STAGE_B(PG8_SB(1, 1), B2, o2, 1, hs2, kb3); PG8_STAGE_A(PG8_SA(1, 0), A2, o2, 0, kb3);
            PG8_WAIT_V(8); PG8_WAIT_L(0); PG8_BAR; PG8_MMA(1, 0, At, B0); PG8_MMA(1, 1, At, B1); PG8_BAR; PG8_SCHED;
        }
        if (wr == 0) PG8_BAR;
        E(acc, cur, wr, wc, fr, fq, tid);
        if (!has_next) break;
#pragma unroll
        for (int a = 0; a < 2; ++a)
#pragma unroll
            for (int b = 0; b < 2; ++b)
#pragma unroll
                for (int m = 0; m < 4; ++m)
#pragma unroll
                    for (int n = 0; n < 2; ++n) acc[a][b][m][n] = (f32x4){0.f, 0.f, 0.f, 0.f};
        cur = nxt; cA = nA; cB = nB; chs = nhs; co = no; ++ui;
        if (wr == 1) PG8_BAR;
    }
    PG8_WAIT_V(0);
    PG8_BAR;
#undef PG8_MKOFF
#undef PG8_SA
#undef PG8_SB
#undef PG8_GLDS
#undef PG8_STAGE_A
#undef PG8_STAGE_B
#undef PG8_LDA
#undef PG8_LDB
#undef PG8_MMA
#undef PG8_WAIT_V
#undef PG8_WAIT_L
#undef PG8_BAR
#undef PG8_SCHED
}

typedef const f32x4 (&AccRef)[2][2][4][2];
__device__ __forceinline__ u32x4 pack8(const f32x4 v0, const f32x4 v1) { u32x4 w; w.x = cvt_pk_bf16(v0[0], v0[1]); w.y = cvt_pk_bf16(v0[2], v0[3]); w.z = cvt_pk_bf16(v1[0], v1[1]); w.w = cvt_pk_bf16(v1[2], v1[3]); return w; }

struct EpiP {
    static constexpr bool PERM = true;
    bf16* P; bf16* KB; bf16* VT;
    __device__ __forceinline__ void operator()(AccRef acc, const Unit& u, int wr, int wc, int fr, int fq, int tid) const {
        if (u.sub == 0) {
            const int row0 = u.pm * BM + wr * 64 + fr, col0 = u.pn * BM + wc * 32 + 8 * fq;
#pragma unroll
            for (int ai = 0; ai < 2; ++ai)
#pragma unroll
                for (int m = 0; m < 4; ++m) { bf16* rowp = P + (size_t)(row0 + ai * HALF + m * 16) * NINX + col0;
#pragma unroll
                    for (int bj = 0; bj < 2; ++bj) *(u32x4*)(rowp + bj * HALF) = pack8(acc[ai][bj][m][0], acc[ai][bj][m][1]); }
        } else {
#pragma unroll
            for (int ai = 0; ai < 2; ++ai)
#pragma unroll
                for (int m = 0; m < 4; ++m) { const int row = u.pm * BM + ai * HALF + wr * 64 + m * 16 + fr;
#pragma unroll
                    for (int bj = 0; bj < 2; ++bj)
#pragma unroll
                        for (int n = 0; n < 2; ++n)
#pragma unroll
                            for (int e = 0; e < 4; ++e) { const int col = u.pn * BM + bj * HALF + wc * 32 + 8 * fq + 4 * n + e; const bf16 v = (bf16)f2bf(acc[ai][bj][m][n][e]);
                                if (col < 512) KB[(size_t)row * 512 + col] = v;
                                else { const int c2 = col - 512, hd = c2 >> 7, d = c2 & 127, b = row >> 8, key = row & 255; VT[((size_t)(b * 4 + hd) * 128 + d) * 256 + key] = v; } } }
        }
    }
};
struct EpiMerge {
    static constexpr bool PERM = true;
    const float* bgate; bf16* Gs; bf16* Z;
    __device__ __forceinline__ void operator()(AccRef acc, const Unit& u, int wr, int wc, int fr, int fq, int tid) const {
        const int br = u.sub >> 1; const int col0 = u.pn * BM + wc * 32 + 8 * fq;
        int t2 = tid; asm volatile("" : "+v"(t2));
        bf16* gsp = Gs + (size_t)(t2 >> 3) * 1024 + (t2 & 7) * 8;
        if ((u.sub & 1) == 0) {
            f32x4 bv[2][2];
#pragma unroll
            for (int bj = 0; bj < 2; ++bj)
#pragma unroll
                for (int n = 0; n < 2; ++n) bv[bj][n] = *(const f32x4*)(bgate + br * 1024 + col0 + bj * HALF + 4 * n);
#pragma unroll
            for (int ai = 0; ai < 2; ++ai)
#pragma unroll
                for (int m = 0; m < 4; ++m)
#pragma unroll
                    for (int bj = 0; bj < 2; ++bj) { f32x4 v0 = acc[ai][bj][m][0] + bv[bj][0], v1 = acc[ai][bj][m][1] + bv[bj][1];
#pragma unroll
                        for (int e = 0; e < 4; ++e) { v0[e] = sigmoidf_(v0[e]); v1[e] = sigmoidf_(v1[e]); }
                        *(u32x4*)(gsp + ((ai * 4 + m) * 2 + bj) * 64) = pack8(v0, v1); }
        } else {
            const int row0 = u.pm * BM + wr * 64 + fr;
#pragma unroll
            for (int ai = 0; ai < 2; ++ai)
#pragma unroll
                for (int m = 0; m < 4; ++m) { bf16* zrow = Z + (size_t)(row0 + ai * HALF + m * 16) * 1024 + col0;
#pragma unroll
                    for (int bj = 0; bj < 2; ++bj) { const u32x4 g = *(const u32x4*)(gsp + ((ai * 4 + m) * 2 + bj) * 64);
                        f32x4 v0 = acc[ai][bj][m][0], v1 = acc[ai][bj][m][1];
                        v0[0] *= bflo(g.x); v0[1] *= bfhi(g.x); v0[2] *= bflo(g.y); v0[3] *= bfhi(g.y); v1[0] *= bflo(g.z); v1[1] *= bfhi(g.z); v1[2] *= bflo(g.w); v1[3] *= bfhi(g.w);
                        if (br > 0) { const u32x4 z = *(const u32x4*)(zrow + bj * HALF);
                            v0[0] += bflo(z.x); v0[1] += bfhi(z.x); v0[2] += bflo(z.y); v0[3] += bfhi(z.y); v1[0] += bflo(z.z); v1[1] += bfhi(z.z); v1[2] += bflo(z.w); v1[3] += bfhi(z.w); }
                        *(u32x4*)(zrow + bj * HALF) = pack8(v0, v1); } }
        }
    }
};
struct EpiX2 {
    static constexpr bool PERM = false;
    const float* x; float* out;
    __device__ __forceinline__ void operator()(AccRef acc, const Unit& u, int wr, int wc, int fr, int fq, int tid) const {
        const int row0 = u.pm * BM + wr * 64 + fr, col0 = u.pn * BM + wc * 32 + 4 * fq;
#pragma unroll
        for (int ai = 0; ai < 2; ++ai)
#pragma unroll
            for (int m = 0; m < 4; ++m) { const size_t off = (size_t)(row0 + ai * HALF + m * 16) * 1024 + col0;
#pragma unroll
                for (int bj = 0; bj < 2; ++bj)
#pragma unroll
                    for (int n = 0; n < 2; ++n) *(f32x4*)(out + off + bj * HALF + n * 16) = *(const f32x4*)(x + off + bj * HALF + n * 16) + acc[ai][bj][m][n]; }
    }
};
struct EpiHid {
    static constexpr bool PERM = true;
    bf16* HID;
    __device__ __forceinline__ void operator()(AccRef acc, const Unit& u, int wr, int wc, int fr, int fq, int tid) const {
        const int row0 = u.pm * BM + wr * 64 + fr, col0 = u.pn * HALF + wc * 32 + 8 * fq;
#pragma unroll
        for (int ai = 0; ai < 2; ++ai)
#pragma unroll
            for (int m = 0; m < 4; ++m) { f32x4 v0, v1;
#pragma unroll
                for (int e = 0; e < 4; ++e) { const float g0 = acc[ai][0][m][0][e], g1 = acc[ai][0][m][1][e]; v0[e] = g0 * sigmoidf_(g0) * acc[ai][1][m][0][e]; v1[e] = g1 * sigmoidf_(g1) * acc[ai][1][m][1][e]; }
                *(u32x4*)(HID + (size_t)(row0 + ai * HALF + m * 16) * DEXP + col0) = pack8(v0, v1); }
    }
};
struct EpiY {
    static constexpr bool PERM = true;
    bf16* Y;
    __device__ __forceinline__ void operator()(AccRef acc, const Unit& u, int wr, int wc, int fr, int fq, int tid) const {
        const int row0 = u.pm * BM + wr * 64 + fr, col0 = u.pn * BM + wc * 32 + 8 * fq;
#pragma unroll
        for (int ai = 0; ai < 2; ++ai)
#pragma unroll
            for (int m = 0; m < 4; ++m) { bf16* rowp = Y + (size_t)(row0 + ai * HALF + m * 16) * 1024 + col0;
#pragma unroll
                for (int bj = 0; bj < 2; ++bj) *(u32x4*)(rowp + bj * HALF) = pack8(acc[ai][bj][m][0], acc[ai][bj][m][1]); }
    }
};

struct SchedP1 {
    int G, c; const char *H, *MEMN, *WIN, *WKV;
    __device__ __forceinline__ bool next(int i, Unit& u) const {
        int L = i * G + c;
        if (L < 1024) { int pm, pn; tile_map(L, 64, 16, pm, pn); u.pm = pm; u.pn = pn; u.sub = 0; u.nt = 16; u.lda = 1024; u.arow0 = pm * 256; u.nrows = 0; u.abase = H; u.pb = WIN + (size_t)pn * 256 * 2048; u.rows = nullptr; return true; }
        L -= 1024;
        if (L < 8) { const int pm = L >> 2, pn = L & 3; u.pm = pm; u.pn = pn; u.sub = 1; u.nt = 16; u.lda = 1024; u.arow0 = pm * 256; u.nrows = 0; u.abase = MEMN; u.pb = WKV + (size_t)pn * 256 * 2048; u.rows = nullptr; return true; }
        return false;
    }
};
struct SchedMerge {
    int G, c; const char *H, *YB, *WGT, *WBR;
    __device__ __forceinline__ bool next(int i, Unit& u) const {
        const int k = i / 6, sub = i - 6 * k; const int L = k * G + c; if (L >= 256) return false;
        int pm, pn; tile_map(L, 64, 4, pm, pn); const int br = sub >> 1;
        u.pm = pm; u.pn = pn; u.sub = sub; u.arow0 = pm * 256; u.nrows = 0; u.rows = nullptr;
        if ((sub & 1) == 0) { u.nt = 16; u.lda = 1024; u.abase = H; u.pb = WGT + ((size_t)(br * 1024 + pn * 256)) * 2048; }
        else { u.nt = 8; u.lda = 512; u.abase = YB + (size_t)br * T * 1024; u.pb = WBR + ((size_t)(br * 1024 + pn * 256)) * 1024; }
        return true;
    }
};
struct SchedX2 {
    int G, c; const char *Z, *WO;
    __device__ __forceinline__ bool next(int i, Unit& u) const {
        const int L = i * G + c; if (L >= 256) return false;
        int pm, pn; tile_map(L, 64, 4, pm, pn);
        u.pm = pm; u.pn = pn; u.sub = 0; u.nt = 16; u.lda = 1024; u.arow0 = pm * 256; u.nrows = 0; u.rows = nullptr; u.abase = Z; u.pb = WO + (size_t)pn * 256 * 2048; return true;
    }
};
constexpr int MOE_MAXU = 8;
struct SchedMoe {
    const volatile LAS int* tab; int phase;
    const char *H2, *HID, *W1, *W2; const int* LIST;
    __device__ __forceinline__ bool next(int i, Unit& u) const {
        if (i >= MOE_MAXU) return false;
        const int e = tab[136 + 4 * i]; if (e < 0) return false;
        const int gt = tab[136 + 4 * i + 1], pn = tab[136 + 4 * i + 2], rt = tab[136 + 4 * i + 3];
        u.pm = gt; u.pn = pn; u.sub = e;
        if (phase == 1) { u.nt = 16; u.lda = 1024; u.arow0 = 0; u.abase = H2; u.rows = LIST + (size_t)e * T + rt * 256; const int c = tab[e] - rt * 256; u.nrows = c < 256 ? c : 256; u.pb = W1 + ((size_t)e * 1024 + pn * 256) * 2048; }
        else { u.nt = 8; u.lda = 512; u.arow0 = gt * 256; u.abase = HID; u.rows = nullptr; u.nrows = 0; u.pb = W2 + ((size_t)e * 1024 + pn * 256) * 1024; }
        return true;
    }
};
}

#define XB_TMO      128
#define XB_XCNT(j)  (256  + 64 * (j))
#define XB_XSUB(j)  (1280 + 64 * (j))
#define XB_XGEN(j)  (2304 + 64 * (j))
#define XB_TOP      3328
#define XB_TOPGEN   3392
#define XCD_BAR_WORDS 3456
#define XB_SPIN_CAP (1u << 18)
__device__ __forceinline__ unsigned xb_ld(unsigned* p)              { return __hip_atomic_load(p, __ATOMIC_RELAXED, __HIP_MEMORY_SCOPE_AGENT); }
__device__ __forceinline__ unsigned xb_add(unsigned* p, unsigned v) { return __hip_atomic_fetch_add(p, v, __ATOMIC_RELAXED, __HIP_MEMORY_SCOPE_AGENT); }
__device__ __forceinline__ unsigned xb_xcc_id() { return (unsigned)__builtin_amdgcn_s_getreg((3 << 11) | 20) & 0xFu; }
#define XB_SPIN(cond, bar) do { unsigned _sp = 0; while (cond) { __builtin_amdgcn_s_sleep(1); \
    if ((++_sp & 255u) == 0u) { if (xb_ld(&(bar)[XB_TMO])) break; if (_sp > XB_SPIN_CAP) { atomicAdd(&(bar)[XB_TMO], 1u); break; } } } } while (0)
struct XcdBarrier { unsigned* bar; unsigned x; volatile LAS unsigned* st; };
__device__ __forceinline__ XcdBarrier xcd_barrier_post(unsigned* bar, volatile LAS unsigned* st) {
    XcdBarrier b; b.bar = bar; b.x = xb_xcc_id(); b.st = st;
    if (threadIdx.x == 0) (void)xb_add(&bar[XB_XCNT(b.x)], 1u);
    return b;
}
__device__ __forceinline__ void xcd_barrier_complete(unsigned* bar, unsigned x, unsigned& nloc, unsigned& nx) {
    const unsigned G = gridDim.x * gridDim.y * gridDim.z;
    unsigned sum, cnt, mine, sp = 0u;
    for (;;) {
        sum = 0u; cnt = 0u; mine = 0u;
#pragma unroll
        for (unsigned j = 0; j < 16; ++j) { const unsigned c = xb_ld(&bar[XB_XCNT(j)]); sum += c; cnt += (c > 0u) ? 1u : 0u; mine = (j == x) ? c : mine; }
        if (sum == G) break;
        __builtin_amdgcn_s_sleep(1);
        if ((++sp & 255u) == 0u) { if (xb_ld(&bar[XB_TMO])) break; if (sp > XB_SPIN_CAP) { atomicAdd(&bar[XB_TMO], 1u); break; } }
    }
    nloc = mine > 0u ? mine : 1u; nx = cnt > 0u ? cnt : 1u;
}
__device__ __forceinline__ void xcd_barrier(const XcdBarrier& b) {
    asm volatile("s_waitcnt vmcnt(0)" ::: "memory");
    __syncthreads();
    if (threadIdx.x == 0) {
        unsigned* bar = b.bar;
        __builtin_amdgcn_s_waitcnt(0);
        unsigned nloc = b.st[0], nx = b.st[1];
        if (nloc == 0u) { xcd_barrier_complete(bar, b.x, nloc, nx); b.st[0] = nloc; b.st[1] = nx; }
        const unsigned old = xb_add(&bar[XB_XSUB(b.x)], 1u);
        const unsigned gen = old / nloc;
        if (old + 1u == (gen + 1u) * nloc) {
            __builtin_amdgcn_fence(__ATOMIC_RELEASE, "agent");
            asm volatile("s_waitcnt vmcnt(0)" ::: "memory");
            const unsigned og = xb_add(&bar[XB_TOP], 1u);
            const unsigned tg = og / nx;
            if (og + 1u == (tg + 1u) * nx) xb_add(&bar[XB_TOPGEN], 1u);
            else XB_SPIN(xb_ld(&bar[XB_TOPGEN]) == tg, bar);
            __builtin_amdgcn_fence(__ATOMIC_ACQUIRE, "agent");
            xb_add(&bar[XB_XGEN(b.x)], 1u);
            asm volatile("s_waitcnt vmcnt(0)" ::: "memory");
        } else {
            XB_SPIN(xb_ld(&bar[XB_XGEN(b.x)]) == gen, bar);
            __builtin_amdgcn_fence(__ATOMIC_ACQUIRE, "agent");
            asm volatile("s_waitcnt vmcnt(0)" ::: "memory");
        }
    }
    __syncthreads();
}

constexpr int NWAVES = 8;
struct Args { const float* in[35]; float* out; unsigned char* ws; int ph_lo, ph_hi; };
struct Frame {
    LAS unsigned char* lds;
    volatile LAS unsigned* MISC;
    gu32* ctl;
    int tid, lane, wave, vcu, G;
    float* out; unsigned char* ws;
};

__device__ __forceinline__ void transpose_item(const float* W, int ldw, int K, int k0, int n0, bf16* WT, int drow0, const float* sc, int mode, LAS float* scr, int lane) {
#pragma unroll 8
    for (int i = 0; i < 32; ++i) { const int kk = 2 * i + (lane >> 5); float v = W[(size_t)(k0 + kk) * ldw + n0 + (lane & 31)];
        if (mode) { const float s = sc[k0 + kk]; v *= (mode == 1) ? s : (1.0f - s); }
        scr[kk * 33 + (lane & 31)] = v; }
    LDS_WAIT(); asm volatile("" ::: "memory");
    const int c = lane & 7;
#pragma unroll
    for (int j = 0; j < 4; ++j) { const int n = (lane >> 3) + 8 * j; const LAS float* s = scr + (8 * c) * 33 + n;
        u32x4 o; o.x = pk2(s[0 * 33], s[1 * 33]); o.y = pk2(s[2 * 33], s[3 * 33]); o.z = pk2(s[4 * 33], s[5 * 33]); o.w = pk2(s[6 * 33], s[7 * 33]);
        *(GAS u32x4*)(WT + (size_t)(drow0 + n) * K + k0 + 8 * c) = o; }
    LDS_WAIT(); asm volatile("" ::: "memory");
}
__device__ __forceinline__ void rms_row_to_bf16(const float* xrow, const float* g, bf16* orow, int lane) {
    const GAS f32x4* xr = (const GAS f32x4*)xrow + lane; const GAS f32x4* gr = (const GAS f32x4*)g + lane;
    f32x4 v[4]; float s = 0.f;
#pragma unroll
    for (int j = 0; j < 4; ++j) { v[j] = xr[64 * j]; s += (v[j].x * v[j].x + v[j].y * v[j].y) + (v[j].z * v[j].z + v[j].w * v[j].w); }
    const float rinv = 1.0f / sqrtf(wave_sum(s) * (1.f / D) + NORM_EPS);
    GAS unsigned long long* o8 = (GAS unsigned long long*)orow + lane;
#pragma unroll
    for (int j = 0; j < 4; ++j) { const f32x4 gv = gr[64 * j]; const f32x4 o = v[j] * rinv * gv; o8[64 * j] = (unsigned long long)pk2(o.x, o.y) | ((unsigned long long)pk2(o.z, o.w) << 32); }
}

__device__ __forceinline__ void p0_prologue(Frame& F, const Args& A) {
    LAS float* scr = (LAS float*)(F.lds + F.wave * 16384);
    const int gw = F.vcu * NWAVES + F.wave, NGW = F.G * NWAVES;
    bf16* WIN = (bf16*)(F.ws + WS_WIN); bf16* WGT = (bf16*)(F.ws + WS_WGATE); bf16* WBR = (bf16*)(F.ws + WS_WBR); bf16* WO = (bf16*)(F.ws + WS_WO); bf16* WKV = (bf16*)(F.ws + WS_WKV);
    constexpr int I_IN = 16 * 112, I_LO = 16 * 8, I_G = 16 * 96, I_BR = 8 * 32, I_O = 16 * 32, I_KV = 16 * 32;
    constexpr int NITEMS = I_IN + 2 * I_LO + I_G + 3 * I_BR + I_O + I_KV;
    for (int it = gw; it < NITEMS; it += NGW) {
        int r = it;
        if (r < I_IN) { const int kb = r / 112, nb = r % 112; transpose_item(A.in[4], 3584, 1024, 64 * kb, 32 * nb, WIN, 32 * nb, nullptr, 0, scr, F.lane); continue; } r -= I_IN;
        if (r < 2 * I_LO) { const int part = r / I_LO; r -= part * I_LO; const int kb = r / 8, nb = r % 8;
            const int n = 32 * nb; const float* W; int ldw, nn, mu;
            if (n < 64) { W = A.in[8]; ldw = 64; nn = n; mu = 0; } else if (n < 128) { W = A.in[11]; ldw = 64; nn = n - 64; mu = 1; } else { W = A.in[14]; ldw = 128; nn = n - 128; mu = 2; }
            transpose_item(W, ldw, 1024, 64 * kb, nn, WIN, (part == 0 ? C_LA : C_LB) + n, A.in[7] + mu * 1024, part == 0 ? 2 : 1, scr, F.lane); continue; } r -= 2 * I_LO;
        if (r < I_G) { const int kb = r / 96, nb = r % 96; transpose_item(A.in[23], 3072, 1024, 64 * kb, 32 * nb, WGT, 32 * nb, nullptr, 0, scr, F.lane); continue; } r -= I_G;
        if (r < 3 * I_BR) { const int br = r / I_BR; r -= br * I_BR; const int kb = r / 32, nb = r % 32; transpose_item(A.in[22] + (size_t)br * 512 * 1024, 1024, 512, 64 * kb, 32 * nb, WBR + (size_t)br * 1024 * 512, 32 * nb, nullptr, 0, scr, F.lane); continue; } r -= 3 * I_BR;
        if (r < I_O) { const int kb = r / 32, nb = r % 32; transpose_item(A.in[25], 1024, 1024, 64 * kb, 32 * nb, WO, 32 * nb, nullptr, 0, scr, F.lane); continue; } r -= I_O;
        { const int kb = r / 32, nb = r % 32; transpose_item(A.in[21], 1024, 1024, 64 * kb, 32 * nb, WKV, 32 * nb, nullptr, 0, scr, F.lane); }
    }
    for (int it = gw; it < 64; it += NGW) {
        if (it < 16) transpose_item(A.in[9], 512, 64, 0, 32 * it, (bf16*)(F.ws + WS_W2T), 32 * it, nullptr, 0, scr, F.lane);
        else if (it < 32) transpose_item(A.in[12], 512, 64, 0, 32 * (it - 16), (bf16*)(F.ws + WS_A2T), 32 * (it - 16), nullptr, 0, scr, F.lane);
        else { const int r2 = it - 32; transpose_item(A.in[15], 512, 128, 64 * (r2 >> 4), 32 * (r2 & 15), (bf16*)(F.ws + WS_G2T), 32 * (r2 & 15), nullptr, 0, scr, F.lane); } }
    { bf16* RH = (bf16*)(F.ws + WS_RTHI); bf16* RL = (bf16*)(F.ws + WS_RTLO);
      for (int idx = (F.vcu * NWAVES + F.wave) * 64 + F.lane; idx < 80 * 1024; idx += NGW * 64) { const int n = idx >> 10, k = idx & 1023;
          float w = 0.f; if (n < 8) w = A.in[27][k * 8 + n]; else if (n < 72) w = A.in[29][k * 64 + (n - 8)];
          const unsigned hi = f2bf(w); const float lo = w - bf2f(hi); RH[idx] = (bf16)hi; RL[idx] = (bf16)f2bf(lo); } }
    bf16* H = (bf16*)(F.ws + WS_H); bf16* MEMN = (bf16*)(F.ws + WS_MEMN);
    for (int m = gw; m < T; m += NGW) rms_row_to_bf16(A.in[0] + (size_t)m * D, A.in[2], H + (size_t)m * D, F.lane);
    for (int m = gw; m < NB * MEML; m += NGW) rms_row_to_bf16(A.in[1] + (size_t)m * D, A.in[3], MEMN + (size_t)m * D, F.lane);
}

__device__ __forceinline__ void convert_experts(Frame& F, const Args& A, int gw, int NGW) {
    LAS float* scr = (LAS float*)(F.lds + F.wave * 16384);
    bf16* E1 = (bf16*)(F.ws + WS_E1); bf16* E2 = (bf16*)(F.ws + WS_E2);
    constexpr int PER_E = 256;
    for (int it = gw; it < 3 * NEXP * PER_E; it += NGW) {
        const int mat = it / (NEXP * PER_E); int r = it - mat * (NEXP * PER_E); const int e = r / PER_E; r -= e * PER_E;
        if (mat < 2) { const int kb = r / 16, nb = r % 16, n = 32 * nb;
            transpose_item(A.in[31 + mat] + (size_t)e * 1024 * 512, 512, 1024, 64 * kb, n, E1 + (size_t)e * 1024 * 1024, (n >> 7) * 256 + mat * 128 + (n & 127), nullptr, 0, scr, F.lane); }
        else { const int kb = r / 32, nb = r % 32;
            transpose_item(A.in[33] + (size_t)e * 512 * 1024, 1024, 512, 64 * kb, 32 * nb, E2 + (size_t)e * 1024 * 512, 32 * nb, nullptr, 0, scr, F.lane); }
    }
}

__device__ __forceinline__ void mem_attn_unit(Frame& F, int unit) {
    const bf16* P = (const bf16*)(F.ws + WS_P); const bf16* KB = (const bf16*)(F.ws + WS_KB); const bf16* VT = (const bf16*)(F.ws + WS_VT); bf16* Y = (bf16*)(F.ws + WS_YB) + (size_t)2 * T * DB;
    const int b = unit >> 7, hd = (unit >> 5) & 3, qb = unit & 31;
    const int t0 = b * SEQ + qb * 256 + F.wave * 32, rr = F.lane & 31, h = F.lane >> 5;
    bf16x8 qf[8];
    { const bf16* qrow = P + (size_t)(t0 + rr) * NINX + C_Q + hd * 128 + 8 * h;
#pragma unroll
      for (int ks = 0; ks < 8; ++ks) qf[ks] = *(const GAS bf16x8*)(qrow + 16 * ks); }
    f32x16 s[8];
    const bf16* kbase = KB + (size_t)(b * 256 + rr) * 512 + hd * 128 + 8 * h;
#pragma unroll
    for (int kt = 0; kt < 8; ++kt) { f32x16 a = {0.f, 0.f, 0.f, 0.f, 0.f, 0.f, 0.f, 0.f, 0.f, 0.f, 0.f, 0.f, 0.f, 0.f, 0.f, 0.f};
#pragma unroll
        for (int ks = 0; ks < 8; ++ks) { const bf16x8 kf = *(const GAS bf16x8*)(kbase + (size_t)kt * 32 * 512 + 16 * ks); a = __builtin_amdgcn_mfma_f32_32x32x16_bf16(kf, qf[ks], a, 0, 0, 0); }
        s[kt] = a; }
    float mx = -3.0e38f;
#pragma unroll
    for (int kt = 0; kt < 8; ++kt)
#pragma unroll
        for (int r = 0; r < 16; ++r) mx = fmaxf(mx, s[kt][r]);
    mx = fmaxf(mx, __shfl_xor(mx, 32));
    const float sc = 0.08838834764831845f * 1.4426950408889634f; float sum = 0.f;
#pragma unroll
    for (int kt = 0; kt < 8; ++kt)
#pragma unroll
        for (int r = 0; r < 16; ++r) { const float p = exp2f((s[kt][r] - mx) * sc); s[kt][r] = p; sum += p; }
    sum += __shfl_xor(sum, 32);
    const float inv = 1.0f / sum;
    f32x16 o[4];
#pragma unroll
    for (int dt = 0; dt < 4; ++dt) o[dt] = (f32x16){0.f, 0.f, 0.f, 0.f, 0.f, 0.f, 0.f, 0.f, 0.f, 0.f, 0.f, 0.f, 0.f, 0.f, 0.f, 0.f};
    const bf16* vbase = VT + ((size_t)(b * 4 + hd) * 128 + rr) * 256 + 4 * h;
#pragma unroll
    for (int kt = 0; kt < 8; ++kt)
#pragma unroll
        for (int sp = 0; sp < 2; ++sp) {
            u32x4 pw; pw.x = cvt_pk_bf16(s[kt][8 * sp + 0], s[kt][8 * sp + 1]); pw.y = cvt_pk_bf16(s[kt][8 * sp + 2], s[kt][8 * sp + 3]); pw.z = cvt_pk_bf16(s[kt][8 * sp + 4], s[kt][8 * sp + 5]); pw.w = cvt_pk_bf16(s[kt][8 * sp + 6], s[kt][8 * sp + 7]);
            const bf16x8 pb = __builtin_bit_cast(bf16x8, pw);
#pragma unroll
            for (int dt = 0; dt < 4; ++dt) { const bf16* vp = vbase + (size_t)dt * 32 * 256 + 32 * kt + 16 * sp;
                const u32x2 lo = *(const GAS u32x2*)(vp), hi = *(const GAS u32x2*)(vp + 8);
                const u32x4 vw = {lo.x, lo.y, hi.x, hi.y};
                o[dt] = __builtin_amdgcn_mfma_f32_32x32x16_bf16(__builtin_bit_cast(bf16x8, vw), pb, o[dt], 0, 0, 0); } }
    bf16* yrow = Y + (size_t)(t0 + rr) * DB + hd * 128 + 4 * h;
#pragma unroll
    for (int dt = 0; dt < 4; ++dt)
#pragma unroll
        for (int g = 0; g < 4; ++g) { u32x2 w; w.x = cvt_pk_bf16(o[dt][4 * g] * inv, o[dt][4 * g + 1] * inv); w.y = cvt_pk_bf16(o[dt][4 * g + 2] * inv, o[dt][4 * g + 3] * inv);
            *(GAS u32x2*)(yrow + 32 * dt + 8 * g) = w; }
}

__device__ __forceinline__ void conv_job(Frame& F, const Args& A, int job) {
    const bf16* P = (const bf16*)(F.ws + WS_P); bf16* Y = (bf16*)(F.ws + WS_YB);
    const int c = F.tid, t0 = job * 64;
    const float w0 = A.in[5][c * 3 + 0], w1 = A.in[5][c * 3 + 1], w2 = A.in[5][c * 3 + 2];
    float cu1 = 0.f, cu2 = 0.f;
    if ((t0 & (SEQ - 1)) != 0) { const bf16* p1 = P + (size_t)(t0 - 1) * NINX; const bf16* p2 = P + (size_t)(t0 - 2) * NINX; cu1 = bf2f(p1[C_CG + c]) * bf2f(p1[C_U + c]); cu2 = bf2f(p2[C_CG + c]) * bf2f(p2[C_U + c]); }
#pragma unroll 4
    for (int t = t0; t < t0 + 64; ++t) { const bf16* p = P + (size_t)t * NINX; const float bg = bf2f(p[C_BG + c]), cu = bf2f(p[C_CG + c]) * bf2f(p[C_U + c]);
        Y[(size_t)t * DB + c] = (bf16)f2bf(bg * (w0 * cu2 + w1 * cu1 + w2 * cu)); cu2 = cu1; cu1 = cu; }
}

__device__ __forceinline__ void rwkv_prep_naive(Frame& F, const Args& A, int job) {
    const bf16* P = (const bf16*)(F.ws + WS_P);
    float* NW = (float*)(F.ws + WS_NV); float* NKK = NW + (size_t)T * DB; float* NBB = NKK + (size_t)T * DB; float* NKM = NBB + (size_t)T * DB; float* NVV = NKM + (size_t)T * DB; float* NR = NVV + (size_t)T * DB;
    bf16* GG = (bf16*)(F.ws + WS_GG); float* CB = (float*)(F.ws + WS_CB);
    LAS float* act = (LAS float*)F.lds;
    const int c = F.tid, hd = c >> 6;
    const float mu_r = A.in[6][c], mu_k = A.in[6][512 + c], mu_v = A.in[6][1024 + c];
    const float w0c = A.in[10][c], a0c = A.in[13][c], kkc = A.in[16][c], kac = A.in[17][c], rkc = A.in[18][c];
    for (int blk = 0; blk < 8; ++blk) {
        const int tb = job * 64 + blk * 8;
        if (c < 256) {
#pragma unroll
            for (int tk = 0; tk < 8; ++tk) { const int t = tb + tk; float v = bf2f(P[(size_t)t * NINX + C_LA + c]); if ((t & (SEQ - 1)) != 0) v += bf2f(P[(size_t)(t - 1) * NINX + C_LB + c]);
                if (c < 64) v = tanhf(v); else if (c >= 128) v = sigmoidf_(v);
                act[c * 8 + tk] = v; }
        }
        __syncthreads();
        float dw[8], da[8], dg[8];
#pragma unroll
        for (int k = 0; k < 8; ++k) { dw[k] = 0.f; da[k] = 0.f; dg[k] = 0.f; }
        for (int n = 0; n < 64; ++n) { const float wv = A.in[9][n * 512 + c], av = A.in[12][n * 512 + c];
            const f32x4 x0 = *(const LAS f32x4*)(act + n * 8), x1 = *(const LAS f32x4*)(act + n * 8 + 4), y0 = *(const LAS f32x4*)(act + (64 + n) * 8), y1 = *(const LAS f32x4*)(act + (64 + n) * 8 + 4);
#pragma unroll
            for (int k = 0; k < 4; ++k) { dw[k] += x0[k] * wv; dw[4 + k] += x1[k] * wv; da[k] += y0[k] * av; da[4 + k] += y1[k] * av; } }
        for (int n = 0; n < 128; ++n) { const float gv = A.in[15][n * 512 + c];
            const f32x4 x0 = *(const LAS f32x4*)(act + (128 + n) * 8), x1 = *(const LAS f32x4*)(act + (128 + n) * 8 + 4);
#pragma unroll
            for (int k = 0; k < 4; ++k) { dg[k] += x0[k] * gv; dg[4 + k] += x1[k] * gv; } }
        float rp_p = 0.f, kp_p = 0.f, vp_p = 0.f;
        if ((tb & (SEQ - 1)) != 0) { const bf16* pp = P + (size_t)(tb - 1) * NINX; rp_p = bf2f(pp[C_RP + c]); kp_p = bf2f(pp[C_KP + c]); vp_p = bf2f(pp[C_VP + c]); }
#pragma unroll
        for (int tk = 0; tk < 8; ++tk) { const int t = tb + tk; const bf16* p = P + (size_t)t * NINX;
            const float rp = bf2f(p[C_RP + c]), kp = bf2f(p[C_KP + c]), vp = bf2f(p[C_VP + c]);
            const float r = rp + (rp_p - rp) * mu_r, k = kp + (kp_p - kp) * mu_k, v = vp + (vp_p - vp) * mu_v;
            rp_p = rp; kp_p = kp; vp_p = vp;
            const float xw = -(w0c + dw[tk]); const float sp = fmaxf(xw, 0.f) + log1pf(__expf(-fabsf(xw)));
            const float wl = -sp - 0.5f; const float decay = __expf(-__expf(wl));
            const float a = sigmoidf_(a0c + da[tk]);
            const float kkv = k * kkc; const float n2 = wave_sum(kkv * kkv); const float kk = kkv * (1.0f / sqrtf(fmaxf(n2, 1e-24f)));
            const float km = k * (1.f + (a - 1.f) * kac);
            const float cb = wave_sum(r * km * rkc);
            const size_t o = (size_t)t * DB + c;
            NW[o] = decay; NKK[o] = kk; NBB[o] = kk * a; NKM[o] = km; NVV[o] = v; NR[o] = r; GG[o] = (bf16)f2bf(dg[tk]);
            if (F.lane == 0) CB[(size_t)t * 8 + hd] = cb; }
        __syncthreads();
    }
}
__device__ __forceinline__ void rwkv_scan_naive(Frame& F, const Args& A, int chain) {
    const float* NW = (const float*)(F.ws + WS_NV); const float* NKK = NW + (size_t)T * DB; const float* NBB = NKK + (size_t)T * DB; const float* NKM = NBB + (size_t)T * DB; const float* NVV = NKM + (size_t)T * DB; const float* NR = NVV + (size_t)T * DB;
    const bf16* GG = (const bf16*)(F.ws + WS_GG); const float* CB = (const float*)(F.ws + WS_CB); bf16* Y = (bf16*)(F.ws + WS_YB) + (size_t)T * DB;
    if (F.wave != 0) return;
    LAS float* blk = (LAS float*)F.lds;
    const int b = chain >> 3, hd = chain & 7, lane = F.lane, ch = hd * 64 + lane;
    const float lnw = A.in[19][ch], lnb = A.in[20][ch];
    float s[64];
#pragma unroll
    for (int j = 0; j < 64; ++j) s[j] = 0.f;
    for (int t0 = b * SEQ; t0 < (b + 1) * SEQ; t0 += 16) {
#pragma unroll
        for (int tk = 0; tk < 16; ++tk) { const size_t o = (size_t)(t0 + tk) * DB + ch;
            blk[(tk * 5 + 0) * 64 + lane] = NW[o]; blk[(tk * 5 + 1) * 64 + lane] = NKK[o]; blk[(tk * 5 + 2) * 64 + lane] = NBB[o]; blk[(tk * 5 + 3) * 64 + lane] = NKM[o]; blk[(tk * 5 + 4) * 64 + lane] = NR[o]; }
        LDS_WAIT(); asm volatile("" ::: "memory");
        for (int tk = 0; tk < 16; ++tk) { const int t = t0 + tk; const size_t o = (size_t)t * DB + ch;
            const float v = NVV[o];
            const LAS f32x4* wv = (const LAS f32x4*)(blk + (tk * 5 + 0) * 64); const LAS f32x4* kv = (const LAS f32x4*)(blk + (tk * 5 + 1) * 64); const LAS f32x4* bv = (const LAS f32x4*)(blk + (tk * 5 + 2) * 64);
            const LAS f32x4* mv = (const LAS f32x4*)(blk + (tk * 5 + 3) * 64); const LAS f32x4* rv = (const LAS f32x4*)(blk + (tk * 5 + 4) * 64);
            float sa = 0.f;
#pragma unroll
            for (int j = 0; j < 16; ++j) { const f32x4 k4 = kv[j]; sa += s[4 * j] * k4[0] + s[4 * j + 1] * k4[1] + s[4 * j + 2] * k4[2] + s[4 * j + 3] * k4[3]; }
            sa = -sa; float y = 0.f;
#pragma unroll
            for (int j = 0; j < 16; ++j) { const f32x4 w4 = wv[j], b4 = bv[j], m4 = mv[j], r4 = rv[j];
#pragma unroll
                for (int e = 0; e < 4; ++e) { const float ns = s[4 * j + e] * w4[e] + sa * b4[e] + v * m4[e]; s[4 * j + e] = ns; y += ns * r4[e]; } }
            const float mu = wave_sum(y) * (1.f / 64.f); const float dlt = y - mu; const float var = wave_sum(dlt * dlt) * (1.f / 64.f);
            const float yn = dlt * (1.0f / sqrtf(var + GN_EPS)) * lnw + lnb;
            const float outv = (yn + CB[(size_t)t * 8 + hd] * v) * bf2f(GG[o]);
            Y[o] = (bf16)f2bf(outv); }
        LDS_WAIT(); asm volatile("" ::: "memory");
    }
}

typedef float f32x2_t __attribute__((ext_vector_type(2))); typedef __bf16 bf16x2_t __attribute__((ext_vector_type(2)));
__device__ __forceinline__ unsigned cvtpk(float lo, float hi) { f32x2_t v = {lo, hi}; bf16x2_t b = __builtin_convertvector(v, bf16x2_t); return __builtin_bit_cast(unsigned, b); }
__device__ __forceinline__ f32x16 mfma32(const u32x4 a, const u32x4 b, const f32x16 c) { return __builtin_amdgcn_mfma_f32_32x32x16_bf16(__builtin_bit_cast(bf16x8, a), __builtin_bit_cast(bf16x8, b), c, 0, 0, 0); }
__device__ __forceinline__ void swap32(unsigned& a, unsigned& b) { auto r = __builtin_amdgcn_permlane32_swap(a, b, false, false); a = r[0]; b = r[1]; }
__device__ __forceinline__ void swap4(u32x4& a, u32x4& b) { unsigned a0 = a.x, a1 = a.y, a2 = a.z, a3 = a.w, b0 = b.x, b1 = b.y, b2 = b.z, b3 = b.w; swap32(a0, b0); swap32(a1, b1); swap32(a2, b2); swap32(a3, b3); a = (u32x4){a0, a1, a2, a3}; b = (u32x4){b0, b1, b2, b3}; }
#define F16Z ((f32x16){0.f, 0.f, 0.f, 0.f, 0.f, 0.f, 0.f, 0.f, 0.f, 0.f, 0.f, 0.f, 0.f, 0.f, 0.f, 0.f})
#define PACKC(c, sp) ((u32x4){cvtpk((c)[8 * (sp) + 0], (c)[8 * (sp) + 1]), cvtpk((c)[8 * (sp) + 2], (c)[8 * (sp) + 3]), cvtpk((c)[8 * (sp) + 4], (c)[8 * (sp) + 5]), cvtpk((c)[8 * (sp) + 6], (c)[8 * (sp) + 7])})
#define CROW0(reg) (((reg) & 3) + 8 * ((reg) >> 2))
__device__ __forceinline__ void load_rowfrags(const bf16* Xrm, int lane, u32x4 (&Fr)[2][4]) {
    const bf16* row = Xrm + lane * 256;
#pragma unroll
    for (int g = 0; g < 4; ++g) { const u32x2 a0 = *(const GAS u32x2*)(row + 16 * g), b0 = *(const GAS u32x2*)(row + 16 * g + 4), a1 = *(const GAS u32x2*)(row + 16 * g + 8), b1 = *(const GAS u32x2*)(row + 16 * g + 12);
        u32x4 P0 = {a0.x, a0.y, a1.x, a1.y}, P1 = {b0.x, b0.y, b1.x, b1.y};
        swap4(P0, P1);
        Fr[0][g] = P0; Fr[1][g] = P1; }
}
#define BLOB_ST(base, cidx, f, val) (*(GAS u32x4*)((base) + ((size_t)(cidx) * 8 + (f)) * 1024 + lane * 16) = (val))
#define BLOB_LD(base, cidx, f) (*(const GAS u32x4*)((base) + ((size_t)(cidx) * 8 + (f)) * 1024 + lane * 16))

__device__ __forceinline__ void rwkv_chunk_job(Frame& F, const Args& A, int job) {
    const bf16* P = (const bf16*)(F.ws + WS_P);
    int lane_ = F.lane; asm volatile("" : "+v"(lane_));
    const int lane = lane_, hd = F.wave, tid = hd * 64 + lane, r = lane & 31, h = lane >> 5, t0 = job * 64, c = hd * 64 + lane;
    const bool bstart = (t0 & (SEQ - 1)) == 0;
    LAS unsigned char* actb = F.lds;
    { const int t = tid >> 3, n0 = (tid & 7) * 32; const bf16* pa = P + (size_t)(t0 + t) * NINX + C_LA + n0; const bool hasprev = !(bstart && t == 0);
      const bf16* pb = P + (size_t)(t0 + t - (hasprev ? 1 : 0)) * NINX + C_LB + n0;
#pragma unroll
      for (int q = 0; q < 4; ++q) { const u32x4 wa = *(const GAS u32x4*)(pa + 8 * q); u32x4 wb = *(const GAS u32x4*)(pb + 8 * q); if (!hasprev) wb = (u32x4){0u, 0u, 0u, 0u};
          float v[8]; v[0] = bflo(wa.x) + bflo(wb.x); v[1] = bfhi(wa.x) + bfhi(wb.x); v[2] = bflo(wa.y) + bflo(wb.y); v[3] = bfhi(wa.y) + bfhi(wb.y); v[4] = bflo(wa.z) + bflo(wb.z); v[5] = bfhi(wa.z) + bfhi(wb.z); v[6] = bflo(wa.w) + bflo(wb.w); v[7] = bfhi(wa.w) + bfhi(wb.w);
#pragma unroll
          for (int e = 0; e < 8; ++e) { if (n0 < 64) v[e] = tanhf(v[e]); else if (n0 >= 128) v[e] = sigmoidf_(v[e]); }
          *(LAS u32x4*)(actb + ((size_t)t * 264 + n0 + 8 * q) * 2) = (u32x4){cvtpk(v[0], v[1]), cvtpk(v[2], v[3]), cvtpk(v[4], v[5]), cvtpk(v[6], v[7])}; } }
    __syncthreads();
    const bf16* W2T = (const bf16*)(F.ws + WS_W2T); const bf16* A2T = (const bf16*)(F.ws + WS_A2T); const bf16* G2T = (const bf16*)(F.ws + WS_G2T);
    bf16* GG = (bf16*)(F.ws + WS_GG); float* CB = (float*)(F.ws + WS_CB); float* GC = (float*)(F.ws + WS_GC);
    { f32x16 ag[2][2];
#pragma unroll
      for (int mt = 0; mt < 2; ++mt)
#pragma unroll
          for (int nt = 0; nt < 2; ++nt) ag[mt][nt] = F16Z;
#pragma unroll
      for (int ks = 0; ks < 8; ++ks) { u32x4 af[2];
#pragma unroll
          for (int mt = 0; mt < 2; ++mt) af[mt] = *(const LAS u32x4*)(actb + ((size_t)(32 * mt + r) * 264 + 128 + 16 * ks + 8 * h) * 2);
#pragma unroll
          for (int nt = 0; nt < 2; ++nt) { const u32x4 bfr = *(const GAS u32x4*)(G2T + (size_t)(hd * 64 + 32 * nt + r) * 128 + 16 * ks + 8 * h);
#pragma unroll
              for (int mt = 0; mt < 2; ++mt) ag[mt][nt] = mfma32(af[mt], bfr, ag[mt][nt]); } }
#pragma unroll
      for (int mt = 0; mt < 2; ++mt)
#pragma unroll
          for (int nt = 0; nt < 2; ++nt)
#pragma unroll
              for (int reg = 0; reg < 16; ++reg) GG[(size_t)(t0 + 32 * mt + CROW0(reg) + 4 * h) * DB + hd * 64 + 32 * nt + r] = (bf16)f2bf(ag[mt][nt][reg]); }
    float lw_[64], av_[64];
    { f32x16 aw[2][2], aa[2][2];
#pragma unroll
      for (int mt = 0; mt < 2; ++mt)
#pragma unroll
          for (int nt = 0; nt < 2; ++nt) { aw[mt][nt] = F16Z; aa[mt][nt] = F16Z; }
#pragma unroll
      for (int ks = 0; ks < 4; ++ks) { u32x4 afw[2], afa[2];
#pragma unroll
          for (int mt = 0; mt < 2; ++mt) { afw[mt] = *(const LAS u32x4*)(actb + ((size_t)(32 * mt + r) * 264 + 16 * ks + 8 * h) * 2); afa[mt] = *(const LAS u32x4*)(actb + ((size_t)(32 * mt + r) * 264 + 64 + 16 * ks + 8 * h) * 2); }
#pragma unroll
          for (int nt = 0; nt < 2; ++nt) { const u32x4 bw = *(const GAS u32x4*)(W2T + (size_t)(hd * 64 + 32 * nt + r) * 64 + 16 * ks + 8 * h), ba = *(const GAS u32x4*)(A2T + (size_t)(hd * 64 + 32 * nt + r) * 64 + 16 * ks + 8 * h);
#pragma unroll
              for (int mt = 0; mt < 2; ++mt) { aw[mt][nt] = mfma32(afw[mt], bw, aw[mt][nt]); aa[mt][nt] = mfma32(afa[mt], ba, aa[mt][nt]); } } }
      const float w0c = A.in[10][c], a0c = A.in[13][c];
#pragma unroll
      for (int mt = 0; mt < 2; ++mt)
#pragma unroll
          for (int reg = 0; reg < 16; ++reg) { const float fx = aw[mt][0][reg], fy = aw[mt][1][reg], fp = aa[mt][0][reg], fq = aa[mt][1][reg];
              unsigned x = __float_as_uint(fx), y = __float_as_uint(fy); swap32(x, y);
              unsigned p = __float_as_uint(fp), q = __float_as_uint(fq); swap32(p, q);
              const int tA = 32 * mt + CROW0(reg);
              { const float xw = -(w0c + __builtin_bit_cast(float, x)); const float sp = fmaxf(xw, 0.f) + log1pf(__expf(-fabsf(xw))); lw_[tA] = -__expf(-sp - 0.5f); }
              { const float xw = -(w0c + __builtin_bit_cast(float, y)); const float sp = fmaxf(xw, 0.f) + log1pf(__expf(-fabsf(xw))); lw_[tA + 4] = -__expf(-sp - 0.5f); }
              av_[tA] = sigmoidf_(a0c + __builtin_bit_cast(float, p)); av_[tA + 4] = sigmoidf_(a0c + __builtin_bit_cast(float, q)); } }
    bf16* sb = (bf16*)(F.ws + WS_S2) + ((size_t)job * 8 + hd) * 32768; bf16* sbr = sb + 16384;
    { const float mu_r = A.in[6][c], mu_k = A.in[6][512 + c], mu_v = A.in[6][1024 + c], kkc = A.in[16][c], kac = A.in[17][c], rkc = A.in[18][c];
      float rp_p = 0.f, kp_p = 0.f, vp_p = 0.f, cum = 0.f;
      if (!bstart) { const bf16* pp = P + (size_t)(t0 - 1) * NINX; rp_p = bf2f(pp[C_RP + c]); kp_p = bf2f(pp[C_KP + c]); vp_p = bf2f(pp[C_VP + c]); }
      unsigned pkA[4], pkB[4], pkK[4], pkV[4]; float hA = 0.f, hB = 0.f, hK = 0.f, hV = 0.f;
      const bf16* pl = P + (size_t)t0 * NINX + C_KP + c;
      bf16* ps = sb + lane; bf16* pr = sbr + lane * 256; float* pcb = CB + (size_t)t0 * 8 + hd;
#pragma unroll
      for (int t = 0; t < 64; ++t) {
          asm volatile("" : "+v"(pl), "+v"(ps));
          const float rp = bf2f(pl[-512]), kp = bf2f(pl[0]), vp = bf2f(pl[512]);
          const float r_ = rp + (rp_p - rp) * mu_r, k_ = kp + (kp_p - kp) * mu_k, v_ = vp + (vp_p - vp) * mu_v; rp_p = rp; kp_p = kp; vp_p = vp;
          const float a = av_[t];
          const float kkv = k_ * kkc; const float n2 = wave_sum(kkv * kkv); const float kk = kkv * (1.0f / sqrtf(fmaxf(n2, 1e-24f)));
          const float km = k_ * (1.f + (a - 1.f) * kac);
          const float cb = wave_sum(r_ * km * rkc); if (lane == 0) pcb[t * 8] = cb;
          const float gp = __expf(cum); cum += lw_[t]; const float g = __expf(cum), ig = __expf(-cum);
          const float vA = -kk * gp, vB = kk * a * ig, vK = km * ig, vR = r_ * g;
          ps[0] = (bf16)f2bf(vA); ps[64] = (bf16)f2bf(vB); ps[128] = (bf16)f2bf(vK); ps[192] = (bf16)f2bf(vR);
          if ((t & 1) == 0) { hA = vA; hB = vB; hK = vK; hV = v_; }
          else { pkA[(t & 7) >> 1] = cvtpk(hA, vA); pkB[(t & 7) >> 1] = cvtpk(hB, vB); pkK[(t & 7) >> 1] = cvtpk(hK, vK); pkV[(t & 7) >> 1] = cvtpk(hV, v_); }
          if ((t & 7) == 7) { const int o = t - 7;
              *(GAS u32x4*)(pr + o) = (u32x4){pkA[0], pkA[1], pkA[2], pkA[3]}; *(GAS u32x4*)(pr + 64 + o) = (u32x4){pkB[0], pkB[1], pkB[2], pkB[3]};
              *(GAS u32x4*)(pr + 128 + o) = (u32x4){pkK[0], pkK[1], pkK[2], pkK[3]}; *(GAS u32x4*)(pr + 192 + o) = (u32x4){pkV[0], pkV[1], pkV[2], pkV[3]}; }
          pl += NINX; ps += 256; }
      GC[((size_t)job * 8 + hd) * 64 + lane] = __expf(cum); }
    VM_WAIT();
    __syncthreads();
    const bf16 *At_tm = sb, *Bt_tm = sb + 64, *Kt_tm = sb + 128, *Rt_tm = sb + 192, *At_rm = sbr, *Bt_rm = sbr + 64, *Kt_rm = sbr + 128, *V_rm = sbr + 192;
#define FRAG_TM(X, tile, ks) (*(const GAS u32x4*)((X) + (32 * (tile) + r) * 256 + 16 * (ks) + 8 * h))
    LAS float* NT = (LAS float*)(F.lds + F.wave * 17408);
    const int cidx = job * 8 + hd;
    unsigned char* outb = (unsigned char*)F.out;
    const float gC0 = GC[(size_t)cidx * 64 + r], gC1 = GC[(size_t)cidx * 64 + 32 + r];
    u32x4 P2[2][2][2], P3[2][2][2];
    { u32x4 Af[2][4], Bf[2][4];
#pragma unroll
      for (int tl = 0; tl < 2; ++tl)
#pragma unroll
          for (int ks = 0; ks < 4; ++ks) { Af[tl][ks] = FRAG_TM(At_tm, tl, ks); Bf[tl][ks] = FRAG_TM(Bt_tm, tl, ks); }
#pragma unroll
      for (int mt = 0; mt < 2; ++mt)
#pragma unroll
          for (int nt = 0; nt < 2; ++nt) { if (mt == 1 && nt == 0) continue; f32x16 acc = F16Z;
#pragma unroll
              for (int ks = 0; ks < 4; ++ks) acc = mfma32(Bf[mt][ks], Af[nt][ks], acc);
#pragma unroll
              for (int g4 = 0; g4 < 4; ++g4) *(LAS f32x4*)(NT + (32 * nt + r) * 68 + 32 * mt + 8 * g4 + 4 * h) = (f32x4){acc[4 * g4], acc[4 * g4 + 1], acc[4 * g4 + 2], acc[4 * g4 + 3]}; }
      { u32x4 Kf[2][4];
#pragma unroll
        for (int tl = 0; tl < 2; ++tl)
#pragma unroll
            for (int ks = 0; ks < 4; ++ks) Kf[tl][ks] = FRAG_TM(Kt_tm, tl, ks);
#pragma unroll
        for (int mt = 0; mt < 2; ++mt)
#pragma unroll
            for (int nt = 0; nt < 2; ++nt) { f32x16 acc = F16Z;
                if (!(mt == 0 && nt == 1)) {
#pragma unroll
                    for (int ks = 0; ks < 4; ++ks) acc = mfma32(Af[mt][ks], Kf[nt][ks], acc);
                    if (mt == nt) {
#pragma unroll
                        for (int reg = 0; reg < 16; ++reg) acc[reg] = (r < CROW0(reg) + 4 * h) ? acc[reg] : 0.f; } }
                P2[mt][nt][0] = PACKC(acc, 0); P2[mt][nt][1] = PACKC(acc, 1); } }
      { u32x4 Rf[2][4];
#pragma unroll
        for (int tl = 0; tl < 2; ++tl)
#pragma unroll
            for (int ks = 0; ks < 4; ++ks) Rf[tl][ks] = FRAG_TM(Rt_tm, tl, ks);
#pragma unroll
        for (int mt = 0; mt < 2; ++mt)
#pragma unroll
            for (int nt = 0; nt < 2; ++nt) { f32x16 acc = F16Z;
                if (!(mt == 1 && nt == 0)) {
#pragma unroll
                    for (int ks = 0; ks < 4; ++ks) acc = mfma32(Bf[mt][ks], Rf[nt][ks], acc);
                    if (mt == nt) {
#pragma unroll
                        for (int reg = 0; reg < 16; ++reg) acc[reg] = (CROW0(reg) + 4 * h <= r) ? acc[reg] : 0.f; } }
                P3[mt][nt][0] = PACKC(acc, 0); P3[mt][nt][1] = PACKC(acc, 1); } } }
    LDS_WAIT(); asm volatile("" ::: "memory");
    u32x4 TA[2][4];
    { float Tr[64];
#pragma unroll
      for (int t = 0; t < 64; ++t) { float col = (lane == t) ? 1.f : 0.f;
#pragma unroll
          for (int q = 0; q < (t + 3) / 4; ++q) { const f32x4 nv = *(const LAS f32x4*)(NT + t * 68 + 4 * q);
#pragma unroll
              for (int e = 0; e < 4; ++e) if (4 * q + e < t) col += Tr[4 * q + e] * nv[e]; }
          Tr[t] = col; }
#pragma unroll
      for (int g = 0; g < 4; ++g) { u32x4 P0 = {cvtpk(Tr[16 * g], Tr[16 * g + 1]), cvtpk(Tr[16 * g + 2], Tr[16 * g + 3]), cvtpk(Tr[16 * g + 8], Tr[16 * g + 9]), cvtpk(Tr[16 * g + 10], Tr[16 * g + 11])};
          u32x4 P1 = {cvtpk(Tr[16 * g + 4], Tr[16 * g + 5]), cvtpk(Tr[16 * g + 6], Tr[16 * g + 7]), cvtpk(Tr[16 * g + 12], Tr[16 * g + 13]), cvtpk(Tr[16 * g + 14], Tr[16 * g + 15])};
          swap4(P0, P1); TA[0][g] = P0; TA[1][g] = P1; } }
    u32x4 P5a[2][2][2], P5b[2][2][2];
    { u32x4 BB[2][4]; load_rowfrags(Bt_rm, lane, BB);
#pragma unroll
      for (int mt = 0; mt < 2; ++mt)
#pragma unroll
          for (int nt = 0; nt < 2; ++nt) { f32x16 acc = F16Z;
#pragma unroll
              for (int g = 0; g < 4; ++g) { if ((g >> 1) == 1 && nt == 0) continue; acc = mfma32(TA[mt][g], P3[g >> 1][nt][g & 1], acc); }
              P5a[mt][nt][0] = PACKC(acc, 0); P5a[mt][nt][1] = PACKC(acc, 1);
              acc = F16Z;
#pragma unroll
              for (int g = 0; g < 4; ++g) acc = mfma32(TA[mt][g], BB[nt][g], acc);
              P5b[mt][nt][0] = PACKC(acc, 0); P5b[mt][nt][1] = PACKC(acc, 1); } }
    u32x4 Q2P[2][2][2], HP[2][2][2];
    { u32x4 Kf[2][4], Rf[2][4];
#pragma unroll
      for (int tl = 0; tl < 2; ++tl)
#pragma unroll
          for (int ks = 0; ks < 4; ++ks) { Kf[tl][ks] = FRAG_TM(Kt_tm, tl, ks); Rf[tl][ks] = FRAG_TM(Rt_tm, tl, ks); }
#pragma unroll
      for (int mt = 0; mt < 2; ++mt)
#pragma unroll
          for (int nt = 0; nt < 2; ++nt) { f32x16 acc = F16Z;
              if (!(mt == 1 && nt == 0)) {
#pragma unroll
                  for (int ks = 0; ks < 4; ++ks) acc = mfma32(Kf[mt][ks], Rf[nt][ks], acc);
                  if (mt == nt) {
#pragma unroll
                      for (int reg = 0; reg < 16; ++reg) acc[reg] = (CROW0(reg) + 4 * h <= r) ? acc[reg] : 0.f; } }
#pragma unroll
              for (int m2 = 0; m2 < 2; ++m2)
#pragma unroll
                  for (int sp = 0; sp < 2; ++sp) { if (m2 == 0 && mt == 1) continue; acc = mfma32(P2[m2][mt][sp], P5a[m2][nt][sp], acc); }
              Q2P[mt][nt][0] = PACKC(acc, 0); Q2P[mt][nt][1] = PACKC(acc, 1); } }
#pragma unroll
    for (int mt = 0; mt < 2; ++mt)
#pragma unroll
        for (int nt = 0; nt < 2; ++nt) { f32x16 acc;
#pragma unroll
            for (int g4 = 0; g4 < 4; ++g4) { const u32x2 kv = *(const GAS u32x2*)(Kt_rm + (32 * nt + r) * 256 + 32 * mt + 8 * g4 + 4 * h); acc[4 * g4] = bflo(kv.x); acc[4 * g4 + 1] = bfhi(kv.x); acc[4 * g4 + 2] = bflo(kv.y); acc[4 * g4 + 3] = bfhi(kv.y); }
#pragma unroll
            for (int m2 = 0; m2 < 2; ++m2)
#pragma unroll
                for (int sp = 0; sp < 2; ++sp) { if (m2 == 0 && mt == 1) continue; acc = mfma32(P2[m2][mt][sp], P5b[m2][nt][sp], acc); }
            const float gc = nt ? gC1 : gC0;
#pragma unroll
            for (int reg = 0; reg < 16; ++reg) acc[reg] *= gc;
            HP[mt][nt][0] = PACKC(acc, 0); HP[mt][nt][1] = PACKC(acc, 1); }
    { u32x4 VB[2][4]; load_rowfrags(V_rm, lane, VB);
      unsigned char* bd = F.ws + WS_BD + (size_t)cidx * 16384;
#pragma unroll
      for (int mt = 0; mt < 2; ++mt)
#pragma unroll
          for (int nt = 0; nt < 2; ++nt) { f32x16 acc = F16Z;
#pragma unroll
              for (int m2 = 0; m2 < 2; ++m2)
#pragma unroll
                  for (int sp = 0; sp < 2; ++sp) acc = mfma32(HP[m2][mt][sp], VB[nt][2 * m2 + sp], acc);
#pragma unroll
              for (int g4 = 0; g4 < 4; ++g4) *(GAS f32x4*)(bd + ((size_t)(((mt * 2 + nt) * 4 + g4) * 64 + lane)) * 16) = (f32x4){acc[4 * g4], acc[4 * g4 + 1], acc[4 * g4 + 2], acc[4 * g4 + 3]};
              acc = F16Z;
#pragma unroll
              for (int g = 0; g < 4; ++g) { if ((g >> 1) == 1 && nt == 0) continue; acc = mfma32(VB[mt][g], Q2P[g >> 1][nt][g & 1], acc); }
              BLOB_ST(outb + OUT_BYL, cidx, (mt * 2 + nt) * 2 + 0, PACKC(acc, 0)); BLOB_ST(outb + OUT_BYL, cidx, (mt * 2 + nt) * 2 + 1, PACKC(acc, 1)); } }
    { u32x4 AA[2][4]; load_rowfrags(At_rm, lane, AA);
#pragma unroll
      for (int mt = 0; mt < 2; ++mt)
#pragma unroll
          for (int nt = 0; nt < 2; ++nt) { f32x16 acc;
#pragma unroll
              for (int g4 = 0; g4 < 4; ++g4) { const u32x2 rv = *(const GAS u32x2*)(Rt_tm + (32 * nt + r) * 256 + 32 * mt + 8 * g4 + 4 * h); acc[4 * g4] = bflo(rv.x); acc[4 * g4 + 1] = bfhi(rv.x); acc[4 * g4 + 2] = bflo(rv.y); acc[4 * g4 + 3] = bfhi(rv.y); }
#pragma unroll
              for (int g = 0; g < 4; ++g) acc = mfma32(AA[mt][g], P5a[g >> 1][nt][g & 1], acc);
              BLOB_ST(outb + OUT_BQ1, cidx, (mt * 2 + nt) * 2 + 0, PACKC(acc, 0)); BLOB_ST(outb + OUT_BQ1, cidx, (mt * 2 + nt) * 2 + 1, PACKC(acc, 1));
              acc = F16Z;
#pragma unroll
              for (int g = 0; g < 4; ++g) acc = mfma32(AA[mt][g], P5b[g >> 1][nt][g & 1], acc);
              const float gc = nt ? gC1 : gC0;
#pragma unroll
              for (int reg = 0; reg < 16; ++reg) { float x = acc[reg]; if (mt == nt) x += (CROW0(reg) + 4 * h == r) ? 1.f : 0.f; acc[reg] = x * gc; }
              BLOB_ST(outb + OUT_BG, cidx, (mt * 2 + nt) * 2 + 0, PACKC(acc, 0)); BLOB_ST(outb + OUT_BG, cidx, (mt * 2 + nt) * 2 + 1, PACKC(acc, 1)); } }
#undef FRAG_TM
    __syncthreads();
}

__device__ __forceinline__ void rwkv_chain(Frame& F, int chain, int nt) {
    const int lane = F.lane, b = chain >> 3, hd = chain & 7;
    unsigned char* outb = (unsigned char*)F.out;
    f32x16 st[2] = {F16Z, F16Z};
    u32x4 gp[8]; f32x4 dd[2][4];
#define CH_LOAD(cidx_) do { _Pragma("unroll") for (int f = 0; f < 8; ++f) gp[f] = BLOB_LD(outb + OUT_BG, cidx_, f); \
        _Pragma("unroll") for (int mt = 0; mt < 2; ++mt) _Pragma("unroll") for (int g4 = 0; g4 < 4; ++g4) dd[mt][g4] = *(const GAS f32x4*)(F.ws + WS_BD + (size_t)(cidx_) * 16384 + ((size_t)(((mt * 2 + nt) * 4 + g4) * 64 + lane)) * 16); } while (0)
    CH_LOAD((b * 128) * 8 + hd);
    for (int ch = 0; ch < 128; ++ch) { const int cidx = (b * 128 + ch) * 8 + hd;
        u32x4 g_[8]; f32x16 acc[2];
#pragma unroll
        for (int f = 0; f < 8; ++f) g_[f] = gp[f];
#pragma unroll
        for (int mt = 0; mt < 2; ++mt)
#pragma unroll
            for (int g4 = 0; g4 < 4; ++g4) { acc[mt][4 * g4] = dd[mt][g4][0]; acc[mt][4 * g4 + 1] = dd[mt][g4][1]; acc[mt][4 * g4 + 2] = dd[mt][g4][2]; acc[mt][4 * g4 + 3] = dd[mt][g4][3]; }
        if (ch + 1 < 128) CH_LOAD(cidx + 8);
        u32x4 SP[2][2];
#pragma unroll
        for (int m2 = 0; m2 < 2; ++m2) { SP[m2][0] = PACKC(st[m2], 0); SP[m2][1] = PACKC(st[m2], 1);
            BLOB_ST(outb + OUT_BS, cidx, (m2 * 2 + nt) * 2 + 0, SP[m2][0]); BLOB_ST(outb + OUT_BS, cidx, (m2 * 2 + nt) * 2 + 1, SP[m2][1]); }
#pragma unroll
        for (int mt = 0; mt < 2; ++mt)
#pragma unroll
            for (int m2 = 0; m2 < 2; ++m2)
#pragma unroll
                for (int sp = 0; sp < 2; ++sp) acc[mt] = mfma32(g_[(m2 * 2 + mt) * 2 + sp], SP[m2][sp], acc[mt]);
        st[0] = acc[0]; st[1] = acc[1]; }
#undef CH_LOAD
}

__device__ __forceinline__ void rwkv_out(Frame& F, const Args& A, int cidx) {
    const bf16* P = (const bf16*)(F.ws + WS_P); const bf16* GG = (const bf16*)(F.ws + WS_GG); const float* CB = (const float*)(F.ws + WS_CB); bf16* Y = (bf16*)(F.ws + WS_YB) + (size_t)T * DB;
    int lane_ = F.lane; asm volatile("" : "+v"(lane_));
    const int lane = lane_, r = lane & 31, h = lane >> 5, job = cidx >> 3, hd = cidx & 7, t0 = job * 64;
    const bool bstart = (t0 & (SEQ - 1)) == 0;
    const unsigned char* outb = (const unsigned char*)F.out;
    u32x4 SP[8], Q1[8];
#pragma unroll
    for (int f = 0; f < 8; ++f) { SP[f] = BLOB_LD(outb + OUT_BS, cidx, f); Q1[f] = BLOB_LD(outb + OUT_BQ1, cidx, f); }
    f32x16 y[2][2];
#pragma unroll
    for (int mt = 0; mt < 2; ++mt)
#pragma unroll
        for (int nt = 0; nt < 2; ++nt) { f32x16 acc;
#pragma unroll
            for (int sp = 0; sp < 2; ++sp) { const u32x4 w = BLOB_LD(outb + OUT_BYL, cidx, (mt * 2 + nt) * 2 + sp);
                acc[8 * sp + 0] = bflo(w.x); acc[8 * sp + 1] = bfhi(w.x); acc[8 * sp + 2] = bflo(w.y); acc[8 * sp + 3] = bfhi(w.y); acc[8 * sp + 4] = bflo(w.z); acc[8 * sp + 5] = bfhi(w.z); acc[8 * sp + 6] = bflo(w.w); acc[8 * sp + 7] = bfhi(w.w); }
#pragma unroll
            for (int m2 = 0; m2 < 2; ++m2)
#pragma unroll
                for (int sp = 0; sp < 2; ++sp) acc = mfma32(SP[(m2 * 2 + mt) * 2 + sp], Q1[(m2 * 2 + nt) * 2 + sp], acc);
            y[mt][nt] = acc; }
#pragma unroll
    for (int nt = 0; nt < 2; ++nt) { const int t = t0 + 32 * nt + r;
        float s1 = 0.f;
#pragma unroll
        for (int mt = 0; mt < 2; ++mt)
#pragma unroll
            for (int reg = 0; reg < 16; ++reg) s1 += y[mt][nt][reg];
        s1 += __shfl_xor(s1, 32); const float mu = s1 * (1.f / 64.f); float s2 = 0.f;
#pragma unroll
        for (int mt = 0; mt < 2; ++mt)
#pragma unroll
            for (int reg = 0; reg < 16; ++reg) { const float d = y[mt][nt][reg] - mu; s2 += d * d; }
        s2 += __shfl_xor(s2, 32); const float rstd = 1.0f / sqrtf(s2 * (1.f / 64.f) + GN_EPS);
        const float cb = CB[(size_t)t * 8 + hd]; const bool hasprev = !(bstart && nt == 0 && r == 0);
        const bf16* pv = P + (size_t)t * NINX + C_VP + hd * 64; const bf16* pvp = P + (size_t)(t - (hasprev ? 1 : 0)) * NINX + C_VP + hd * 64;
#pragma unroll
        for (int mt = 0; mt < 2; ++mt)
#pragma unroll
            for (int g4 = 0; g4 < 4; ++g4) { const int i0 = 32 * mt + 8 * g4 + 4 * h;
                const f32x4 lw = *(const GAS f32x4*)(A.in[19] + hd * 64 + i0), lb = *(const GAS f32x4*)(A.in[20] + hd * 64 + i0), mv = *(const GAS f32x4*)(A.in[6] + 1024 + hd * 64 + i0);
                const u32x2 v0 = *(const GAS u32x2*)(pv + i0); u32x2 v1 = *(const GAS u32x2*)(pvp + i0); if (!hasprev) v1 = (u32x2){0u, 0u};
                const u32x2 gg = *(const GAS u32x2*)(GG + (size_t)t * DB + hd * 64 + i0);
                float vv[4], vp_[4], gv[4]; vv[0] = bflo(v0.x); vv[1] = bfhi(v0.x); vv[2] = bflo(v0.y); vv[3] = bfhi(v0.y); vp_[0] = bflo(v1.x); vp_[1] = bfhi(v1.x); vp_[2] = bflo(v1.y); vp_[3] = bfhi(v1.y);
                gv[0] = bflo(gg.x); gv[1] = bfhi(gg.x); gv[2] = bflo(gg.y); gv[3] = bfhi(gg.y);
                float o[4];
#pragma unroll
                for (int e = 0; e < 4; ++e) { const float v = vv[e] + (vp_[e] - vv[e]) * mv[e]; o[e] = ((y[mt][nt][4 * g4 + e] - mu) * rstd * lw[e] + lb[e] + cb * v) * gv[e]; }
                *(GAS u32x2*)(Y + (size_t)t * DB + hd * 64 + i0) = (u32x2){cvtpk(o[0], o[1]), cvtpk(o[2], o[3])}; } }
}

__device__ __forceinline__ void router_job(Frame& F, const Args& A, int job) {
    const float* X2 = F.out; bf16* H2 = (bf16*)(F.ws + WS_H); const bf16* RH = (const bf16*)(F.ws + WS_RTHI); const bf16* RL = (const bf16*)(F.ws + WS_RTLO);
    int* ROUTE = (int*)(F.ws + WS_ROUTE); float* COMB = (float*)(F.ws + WS_ROUTE + 512 * 1024); int* LIST = (int*)(F.ws + WS_LIST); unsigned* CNT = (unsigned*)(F.ctl + CW_CNT);
    LAS float* lg = (LAS float*)(F.lds + F.wave * 8192);
    const int lane = F.lane, row = lane & 15, q = lane >> 4, tb = job * 16;
    const float* xr = X2 + (size_t)(tb + row) * D + 8 * q;
    float ss = 0.f;
#pragma unroll 8
    for (int ks = 0; ks < 32; ++ks) { const f32x4 a = *(const GAS f32x4*)(xr + 32 * ks), b = *(const GAS f32x4*)(xr + 32 * ks + 4); ss += (a.x * a.x + a.y * a.y) + (a.z * a.z + a.w * a.w) + (b.x * b.x + b.y * b.y) + (b.z * b.z + b.w * b.w); }
    ss += __shfl_xor(ss, 16); ss += __shfl_xor(ss, 32);
    const float rinv = 1.0f / sqrtf(ss * (1.f / D) + NORM_EPS);
    f32x4 acc[5];
#pragma unroll
    for (int nt = 0; nt < 5; ++nt) acc[nt] = (f32x4){0.f, 0.f, 0.f, 0.f};
    const float* gf = A.in[26] + 8 * q;
#pragma unroll 2
    for (int ks = 0; ks < 32; ++ks) {
        const f32x4 a = *(const GAS f32x4*)(xr + 32 * ks), b = *(const GAS f32x4*)(xr + 32 * ks + 4); const f32x4 ga = *(const GAS f32x4*)(gf + 32 * ks), gb = *(const GAS f32x4*)(gf + 32 * ks + 4);
        float hv[8]; hv[0] = a.x * rinv * ga.x; hv[1] = a.y * rinv * ga.y; hv[2] = a.z * rinv * ga.z; hv[3] = a.w * rinv * ga.w; hv[4] = b.x * rinv * gb.x; hv[5] = b.y * rinv * gb.y; hv[6] = b.z * rinv * gb.z; hv[7] = b.w * rinv * gb.w;
        unsigned hi[8], lo[8];
#pragma unroll
        for (int e = 0; e < 8; ++e) { hi[e] = f2bf(hv[e]); lo[e] = f2bf(hv[e] - bf2f(hi[e])); }
        const u32x4 hw = {hi[0] | (hi[1] << 16), hi[2] | (hi[3] << 16), hi[4] | (hi[5] << 16), hi[6] | (hi[7] << 16)};
        const u32x4 lw = {lo[0] | (lo[1] << 16), lo[2] | (lo[3] << 16), lo[4] | (lo[5] << 16), lo[6] | (lo[7] << 16)};
        *(GAS u32x4*)(H2 + (size_t)(tb + row) * D + 32 * ks + 8 * q) = hw;
        const bf16x8 ah = __builtin_bit_cast(bf16x8, hw), al = __builtin_bit_cast(bf16x8, lw);
#pragma unroll
        for (int nt = 0; nt < 5; ++nt) { const size_t wo = (size_t)(16 * nt + row) * 1024 + 32 * ks + 8 * q;
            const bf16x8 bh = *(const GAS bf16x8*)(RH + wo), bl = *(const GAS bf16x8*)(RL + wo);
            acc[nt] = __builtin_amdgcn_mfma_f32_16x16x32_bf16(ah, bh, acc[nt], 0, 0, 0);
            acc[nt] = __builtin_amdgcn_mfma_f32_16x16x32_bf16(al, bh, acc[nt], 0, 0, 0);
            acc[nt] = __builtin_amdgcn_mfma_f32_16x16x32_bf16(ah, bl, acc[nt], 0, 0, 0); }
    }
#pragma unroll
    for (int nt = 0; nt < 5; ++nt)
#pragma unroll
        for (int r = 0; r < 4; ++r) lg[(4 * q + r) * 80 + 16 * nt + row] = acc[nt][r];
    LDS_WAIT(); asm volatile("" ::: "memory");
    if (lane < 16) { const int t = tb + lane; const LAS float* l = lg + lane * 80;
        float gl[8]; int gs = 0; float gm = -3.0e38f;
#pragma unroll
        for (int i = 0; i < 8; ++i) { gl[i] = l[i] + A.in[28][i]; if (gl[i] > gm) { gm = gl[i]; gs = i; } }
        float gsum = 0.f;
#pragma unroll
        for (int i = 0; i < 8; ++i) gsum += __expf(gl[i] - gm);
        const float gw = 1.0f / gsum;
        float e0v = -3.0e38f, e1v = -3.0e38f; int i0 = 0, i1 = 0;
#pragma unroll
        for (int i = 0; i < 8; ++i) { const float v = l[8 + gs * 8 + i] + A.in[30][gs * 8 + i];
            if (v > e0v) { e1v = e0v; i1 = i0; e0v = v; i0 = i; } else if (v > e1v) { e1v = v; i1 = i; } }
        const float x = __expf(e1v - e0v); const float c0 = gw / (1.f + x), c1 = gw * x / (1.f + x);
        const int e0 = gs * 8 + i0, e1 = gs * 8 + i1;
        const int p0 = (int)__hip_atomic_fetch_add(CNT + e0, 1u, RLX_AGENT), p1 = (int)__hip_atomic_fetch_add(CNT + e1, 1u, RLX_AGENT);
        LIST[(size_t)e0 * T + p0] = t; LIST[(size_t)e1 * T + p1] = t;
        ROUTE[4 * t + 0] = e0; ROUTE[4 * t + 1] = p0; ROUTE[4 * t + 2] = e1; ROUTE[4 * t + 3] = p1; COMB[2 * t] = c0; COMB[2 * t + 1] = c1; }
    LDS_WAIT(); asm volatile("" ::: "memory");
}

__device__ __forceinline__ void moe_build_table(Frame& F) {
    volatile LAS int* tab = (volatile LAS int*)(F.lds + MOE_OFF);
    if (F.tid < NEXP) tab[F.tid] = (int)__hip_atomic_load((unsigned*)(F.ctl + CW_CNT) + F.tid, RLX_AGENT);
    __syncthreads();
    if (F.tid == 0) { int run = 0;
        for (int e = 0; e < NEXP; ++e) { tab[64 + e] = run; run += (tab[e] + 255) >> 8; }
        tab[128] = run; tab[129] = run;
        const int U = run * 4; int e = 0;
        for (int i = 0; i < pg8::MOE_MAXU; ++i) { const int L = i * F.G + (int)blockIdx.x;
            if (L < U) { const int q = U / 8, r = U % 8, xcd = L % 8, off = L / 8; const int id = (xcd < r ? xcd * (q + 1) : r * (q + 1) + (xcd - r) * q) + off;
                const int gt = id >> 2, pn = id & 3; e = 0; while (e < NEXP - 1 && tab[64 + e + 1] <= gt) ++e;
                tab[136 + 4 * i] = e; tab[136 + 4 * i + 1] = gt; tab[136 + 4 * i + 2] = pn; tab[136 + 4 * i + 3] = gt - tab[64 + e]; }
            else tab[136 + 4 * i] = -1; } }
    __syncthreads();
}
__device__ __forceinline__ void final_rows(Frame& F, const Args& A, int gw, int NGW) {
    volatile LAS int* tab = (volatile LAS int*)(F.lds + MOE_OFF);
    const int* ROUTE = (const int*)(F.ws + WS_ROUTE); const float* COMB = (const float*)(F.ws + WS_ROUTE + 512 * 1024); const bf16* YM = (const bf16*)(F.ws + WS_YMOE);
    for (int t = gw; t < T; t += NGW) {
        const int e0 = ROUTE[4 * t], p0 = ROUTE[4 * t + 1], e1 = ROUTE[4 * t + 2], p1 = ROUTE[4 * t + 3]; const float c0 = COMB[2 * t], c1 = COMB[2 * t + 1];
        const size_t r0 = (size_t)tab[64 + e0] * 256 + p0, r1 = (size_t)tab[64 + e1] * 256 + p1;
        GAS f32x4* xr = (GAS f32x4*)(F.out + (size_t)t * D) + F.lane; const GAS u32x2* y0 = (const GAS u32x2*)(YM + r0 * D) + F.lane; const GAS u32x2* y1 = (const GAS u32x2*)(YM + r1 * D) + F.lane;
        f32x4 v[4]; float s = 0.f;
#pragma unroll
        for (int j = 0; j < 4; ++j) { v[j] = xr[64 * j]; const u32x2 a = y0[64 * j], b = y1[64 * j];
            v[j].x += c0 * bflo(a.x) + c1 * bflo(b.x); v[j].y += c0 * bfhi(a.x) + c1 * bfhi(b.x); v[j].z += c0 * bflo(a.y) + c1 * bflo(b.y); v[j].w += c0 * bfhi(a.y) + c1 * bfhi(b.y);
            s += (v[j].x * v[j].x + v[j].y * v[j].y) + (v[j].z * v[j].z + v[j].w * v[j].w); }
        const float rinv = 1.0f / sqrtf(wave_sum(s) * (1.f / D) + NORM_EPS);
        const GAS f32x4* gr = (const GAS f32x4*)A.in[34] + F.lane;
#pragma unroll
        for (int j = 0; j < 4; ++j) xr[64 * j] = v[j] * rinv * gr[64 * j];
    }
}

constexpr int N_PHASES = 11;
__global__ void __launch_bounds__(NWAVES * 64, 2) mk_fwd(Args args) {
    extern __shared__ __attribute__((aligned(16))) unsigned char lds[];
    Frame F;
    F.lds = (LAS unsigned char*)lds;
    F.MISC = (volatile LAS unsigned*)(F.lds + MISC_OFF);
    F.tid = threadIdx.x; F.lane = F.tid & 63; F.wave = __builtin_amdgcn_readfirstlane(F.tid >> 6);
    F.G = gridDim.x; { const int bx = blockIdx.x; F.vcu = (F.G % 8 == 0) ? (bx % 8) * (F.G / 8) + bx / 8 : bx; }
    unsigned char* ws = args.ws; F.ws = ws; F.out = args.out;
    F.ctl = (gu32*)(ws + WS_CTL);
    for (int u = F.tid; u < (LDS_BYTES - LDSCTL_OFF) / 4; u += NWAVES * 64) ((LAS unsigned*)(F.lds + LDSCTL_OFF))[u] = 0u;
    __syncthreads();
#if MK_MULTI
#define GRID_BAR() do { } while (0)
#else
    XcdBarrier bar = xcd_barrier_post((unsigned*)(F.ctl + CW_BAR), F.MISC + 8);
#define GRID_BAR() xcd_barrier(bar)
#endif
    const int lo = args.ph_lo, hi = args.ph_hi;
#define IN(k) (lo <= (k) && (k) < hi)
#define BOTH(k) (IN(k) && IN((k) + 1))
    const int gw = F.vcu * NWAVES + F.wave, NGW = F.G * NWAVES;
    const char* wsc = (const char*)ws;

    if (IN(0)) { p0_prologue(F, args); if (BOTH(0)) GRID_BAR(); }
    if (IN(1)) {
        pg8::SchedP1 S{F.G, (int)blockIdx.x, wsc + WS_H, wsc + WS_MEMN, wsc + WS_WIN, wsc + WS_WKV};
        pg8::EpiP E{(bf16*)(ws + WS_P), (bf16*)(ws + WS_KB), (bf16*)(ws + WS_VT)};
        pg8::gemm_phase<pg8::EpiP, pg8::SchedP1, false>(F.lds, S, E);
        if (BOTH(1)) GRID_BAR();
    }
    if (IN(2)) {
        for (int j = blockIdx.x; j < T / 64; j += F.G) { rwkv_chunk_job(F, args, j); conv_job(F, args, j); }
        for (int u = blockIdx.x; u < 256; u += F.G) mem_attn_unit(F, u);
        if (BOTH(2)) GRID_BAR();
    }
    if (IN(3)) {
        if (F.G >= 64) {
            if (blockIdx.x < NB * NHEAD) { if (F.wave < 2) rwkv_chain(F, (int)blockIdx.x, F.wave); }
            else convert_experts(F, args, ((int)blockIdx.x - NB * NHEAD) * NWAVES + F.wave, (F.G - NB * NHEAD) * NWAVES);
        } else {
            for (int ch = blockIdx.x; ch < NB * NHEAD; ch += F.G) if (F.wave < 2) rwkv_chain(F, ch, F.wave);
            convert_experts(F, args, gw, NGW);
        }
        if (BOTH(3)) GRID_BAR();
    }
    if (IN(4)) { for (int ci = gw; ci < (T / 64) * NHEAD; ci += NGW) rwkv_out(F, args, ci); if (BOTH(4)) GRID_BAR(); }
    if (IN(5)) {
        pg8::SchedMerge S{F.G, (int)blockIdx.x, wsc + WS_H, wsc + WS_YB, wsc + WS_WGATE, wsc + WS_WBR};
        pg8::EpiMerge E{args.in[24], (bf16*)(ws + WS_GS) + (size_t)blockIdx.x * 65536, (bf16*)(ws + WS_Z)};
        pg8::gemm_phase<pg8::EpiMerge, pg8::SchedMerge, false>(F.lds, S, E);
        if (BOTH(5)) GRID_BAR();
    }
    if (IN(6)) {
        pg8::SchedX2 S{F.G, (int)blockIdx.x, wsc + WS_Z, wsc + WS_WO};
        pg8::EpiX2 E{args.in[0], F.out};
        pg8::gemm_phase<pg8::EpiX2, pg8::SchedX2, false>(F.lds, S, E);
        if (BOTH(6)) GRID_BAR();
    }
    if (IN(7)) { for (int j = gw; j < T / 16; j += NGW) router_job(F, args, j); if (BOTH(7)) GRID_BAR(); }
    if (IN(8)) {
        moe_build_table(F);
        pg8::SchedMoe S{(const volatile LAS int*)(F.lds + MOE_OFF), 1, wsc + WS_H, wsc + WS_HID, wsc + WS_E1, wsc + WS_E2, (const int*)(ws + WS_LIST)};
        pg8::EpiHid E{(bf16*)(ws + WS_HID)};
        pg8::gemm_phase<pg8::EpiHid, pg8::SchedMoe, true>(F.lds, S, E);
        if (BOTH(8)) GRID_BAR();
    }
    if (IN(9)) {
        moe_build_table(F);
        pg8::SchedMoe S{(const volatile LAS int*)(F.lds + MOE_OFF), 2, wsc + WS_H, wsc + WS_HID, wsc + WS_E1, wsc + WS_E2, (const int*)(ws + WS_LIST)};
        pg8::EpiY E{(bf16*)(ws + WS_YMOE)};
        pg8::gemm_phase<pg8::EpiY, pg8::SchedMoe, false>(F.lds, S, E);
        if (BOTH(9)) GRID_BAR();
    }
    if (IN(10)) { moe_build_table(F); final_rows(F, args, gw, NGW); }
#undef IN
#undef BOTH
}

extern "C" void kernel_launch(void* const* d_in, const int* in_sizes, int n_in, void* d_out, int out_size, void* d_ws, size_t ws_size, hipStream_t stream) {
    static int grid = 0;
    if (grid == 0) {
        if (n_in != 35 || in_sizes[0] != T * D || out_size != T * D || ws_size < WS_END) { fprintf(stderr, "kernel_launch: unexpected shapes / workspace (n_in %d, in0 %d, out %d, ws %zu)\n", n_in, n_in > 0 ? in_sizes[0] : -1, out_size, ws_size); grid = -1; return; }
        int dev = 0, cus = 0, per_cu = 0;
        if (hipGetDevice(&dev) != hipSuccess || hipDeviceGetAttribute(&cus, hipDeviceAttributeMultiprocessorCount, dev) != hipSuccess) { grid = -1; return; }
        if (hipFuncSetAttribute((const void*)mk_fwd, hipFuncAttributeMaxDynamicSharedMemorySize, LDS_BYTES) != hipSuccess) { fprintf(stderr, "kernel_launch: hipFuncSetAttribute failed\n"); grid = -1; return; }
        if (hipOccupancyMaxActiveBlocksPerMultiprocessor(&per_cu, (const void*)mk_fwd, NWAVES * 64, LDS_BYTES) != hipSuccess || per_cu < 1) fprintf(stderr, "kernel_launch: occupancy query reports %d\n", per_cu);
        (void)hipGetLastError();
        grid = cus;
    }
    if (grid < 0) return;
    if (hipMemsetAsync((char*)d_ws + WS_CTL, 0, CTL_ZERO_BYTES, stream) != hipSuccess) { fprintf(stderr, "kernel_launch: memset failed\n"); return; }
    Args a{};
    for (int i = 0; i < 35; ++i) a.in[i] = (const float*)d_in[i];
    a.out = (float*)d_out; a.ws = (unsigned char*)d_ws;
#if MK_MULTI
    for (int p = 0; p < N_PHASES; ++p) { a.ph_lo = p; a.ph_hi = p + 1; hipLaunchKernelGGL(mk_fwd, dim3(grid), dim3(NWAVES * 64), LDS_BYTES, stream, a); }
#else
    a.ph_lo = 0; a.ph_hi = N_PHASES; hipLaunchKernelGGL(mk_fwd, dim3(grid), dim3(NWAVES * 64), LDS_BYTES, stream, a);
#endif
    const hipError_t le = hipPeekAtLastError();
    if (le != hipSuccess) fprintf(stderr, "kernel_launch: launch failed: %s\n", hipGetErrorName(le));
}
```

```cpp
#include <hip/hip_runtime.h>
#include <cstdio>
#include <cstdint>

#ifndef MK_MULTI
#define MK_MULTI 0
#endif

#define GAS __attribute__((address_space(1)))
#define LAS __attribute__((address_space(3)))
typedef unsigned short bf16;
typedef short bf16x8 __attribute__((ext_vector_type(8)));
typedef float f32x4 __attribute__((ext_vector_type(4)));
typedef float f32x16 __attribute__((ext_vector_type(16)));
typedef unsigned u32x4 __attribute__((ext_vector_type(4)));
typedef unsigned u32x2 __attribute__((ext_vector_type(2)));

constexpr int NB = 2, SEQ = 8192, T = NB * SEQ, D = 1024, DB = 512, NHEAD = 8, HD = 64;
constexpr int NINX = 4096;
constexpr int MEML = 256, NEXP = 64, DEXP = 512;
constexpr int C_BG = 0, C_CG = 512, C_U = 1024, C_RP = 1536, C_KP = 2048, C_VP = 2560, C_Q = 3072, C_LA = 3584, C_LB = 3840;
constexpr float NORM_EPS = 1e-6f, GN_EPS = 64e-5f;
constexpr int MOE_ROWS = 49152;

constexpr size_t MiB = 1u << 20;
constexpr size_t WS_CTL = 0, CTL_ZERO_BYTES = 1 * MiB;
constexpr size_t WS_WIN = 1 * MiB, WS_WGATE = 9 * MiB, WS_WBR = 15 * MiB, WS_WO = 18 * MiB, WS_WKV = 20 * MiB, WS_MISCW = 22 * MiB;
constexpr size_t WS_RTHI = WS_MISCW, WS_RTLO = WS_MISCW + 256 * 1024;
constexpr size_t WS_W2T = WS_MISCW + 512 * 1024, WS_A2T = WS_MISCW + 576 * 1024, WS_G2T = WS_MISCW + 640 * 1024;
constexpr size_t WS_E1 = 24 * MiB, WS_E2 = 152 * MiB;
constexpr size_t WS_H = 216 * MiB;
constexpr size_t WS_MEMN = 248 * MiB, WS_KB = 249 * MiB, WS_VT = 249 * MiB + 512 * 1024;
constexpr size_t WS_P = 250 * MiB;
constexpr size_t WS_Z = WS_P;
constexpr size_t WS_HID = WS_P, WS_YMOE = 298 * MiB;
constexpr size_t WS_YB = 378 * MiB;
constexpr size_t WS_GS = 426 * MiB;
constexpr size_t WS_GG = 458 * MiB;
constexpr size_t WS_CB = 474 * MiB;
constexpr size_t WS_GC = 474 * MiB + 512 * 1024;
constexpr size_t WS_S2 = WS_E1;
constexpr size_t WS_BD = WS_GS;
constexpr size_t OUT_BG = 0, OUT_BQ1 = 16 * MiB, OUT_BYL = 32 * MiB, OUT_BS = 48 * MiB;
constexpr size_t WS_ROUTE = 475 * MiB;
constexpr size_t WS_LIST = 476 * MiB;
constexpr size_t WS_END = 480 * MiB;
constexpr size_t WS_NV = WS_E1;

constexpr int CW_BAR = 4096;
constexpr int CW_CNT = 16384;

constexpr int RING_BYTES = 131072;
constexpr int LDSCTL_OFF = 139264, MISC_OFF = LDSCTL_OFF + 320, MOE_OFF = LDSCTL_OFF + 1024;
constexpr int LDS_BYTES = 147456;

typedef GAS unsigned gu32;
#define RLX_AGENT __ATOMIC_RELAXED, __HIP_MEMORY_SCOPE_AGENT
#define LDS_WAIT() asm volatile("s_waitcnt lgkmcnt(0)" ::: "memory")
#define VM_WAIT() asm volatile("s_waitcnt vmcnt(0)" ::: "memory")
__device__ __forceinline__ unsigned f2bf(float f) { unsigned u = __builtin_bit_cast(unsigned, f); return (u + 0x7fffu + ((u >> 16) & 1u)) >> 16; }
__device__ __forceinline__ unsigned pk2(float lo, float hi) { return f2bf(lo) | (f2bf(hi) << 16); }
__device__ __forceinline__ float bf2f(unsigned b) { return __builtin_bit_cast(float, b << 16); }
__device__ __forceinline__ float bflo(unsigned w) { return __builtin_bit_cast(float, w << 16); }
__device__ __forceinline__ float bfhi(unsigned w) { return __builtin_bit_cast(float, w & 0xffff0000u); }
__device__ __forceinline__ unsigned cvt_pk_bf16(float lo, float hi) { unsigned r; asm volatile("v_cvt_pk_bf16_f32 %0, %1, %2" : "=v"(r) : "v"(lo), "v"(hi)); return r; }
__device__ __forceinline__ float wave_sum(float v) {
#pragma unroll
    for (int o = 1; o < 64; o <<= 1) v += __shfl_xor(v, o);
    return v;
}
__device__ __forceinline__ float dpp_add(float v, float src_from) { return v + src_from; }
#define DPPF(v, ctrl, rmask) __builtin_bit_cast(float, __builtin_amdgcn_update_dpp(0, __builtin_bit_cast(int, (v)), (ctrl), (rmask), 0xF, false))
__device__ __forceinline__ float wave_sum_dpp(float v) {
    v += DPPF(v, 0xB1, 0xF); v += DPPF(v, 0x4E, 0xF); v += DPPF(v, 0x141, 0xF); v += DPPF(v, 0x140, 0xF);
    v += DPPF(v, 0x142, 0xA); v += DPPF(v, 0x143, 0xC);
    return __builtin_bit_cast(float, __builtin_amdgcn_readlane(__builtin_bit_cast(int, v), 63));
}
__device__ __forceinline__ float sigmoidf_(float x) { return 1.0f / (1.0f + __expf(-x)); }

namespace pg8 {
constexpr int BM = 256, BK = 64, HALF = 128, HTB = HALF * BK * 2, STAGE_BYTES = 8 * HTB;
__host__ __device__ __forceinline__ int lds_byte(int r, int c) { const int st = (r >> 4) * 2 + (c >> 5), rr = r & 15, cc = c & 31, ob = rr * 64 + cc * 2; return st * 1024 + (ob ^ (((ob >> 9) & 1) << 5)); }
__host__ __device__ __forceinline__ void stage_rc(int b, int& R, int& C) { const int st = b / 1024, sb = b % 1024, swz = sb ^ (((sb >> 9) & 1) << 5); R = (st >> 1) * 16 + swz / 64; C = (st & 1) * 32 + (swz % 64) / 2; }
__host__ __device__ __forceinline__ int perm32(int rho) { const int n = rho >> 4, i = rho & 15; return 8 * (i >> 2) + 4 * n + (i & 3); }

struct Unit { int pm, pn, sub, nt, lda, arow0, nrows; const char* abase; const char* pb; const int* rows; };
struct LaneOff { unsigned a[2][2]; unsigned b[2]; };

__device__ __forceinline__ void tile_map(int L, int nM, int nN, int& pm, int& pn) {
    const int nwg = nM * nN; int wgid = L; { const int q = nwg / 8, r = nwg % 8, xcd = wgid % 8, off = wgid / 8; wgid = (xcd < r ? xcd * (q + 1) : r * (q + 1) + (xcd - r) * q) + off; }
    const int nig = 8 * nN, gid = wgid / nig, fm = gid * 8, gsz = (nM - fm) < 8 ? (nM - fm) : 8;
    pm = fm + ((wgid % nig) % gsz); pn = (wgid % nig) / gsz;
}

template <class Epi, class Sched, bool GATHER>
__device__ __forceinline__ void gemm_phase(LAS unsigned char* lds, const Sched& S, const Epi& E) {
    const int tid = threadIdx.x, wid = __builtin_amdgcn_readfirstlane(tid >> 6), lane = tid & 63, wr = wid >> 2, wc = wid & 3, fr = lane & 15, fq = lane >> 4;
    int R_[2], C_[2], Rb_[2];
#pragma unroll
    for (int i = 0; i < 2; ++i) { int R, C; stage_rc(tid * 16 + i * 8192, R, C); R_[i] = R; C_[i] = C; Rb_[i] = Epi::PERM ? ((R & ~31) + perm32(R & 31)) : R; }
    const unsigned ldsw = (unsigned)wid * 1024u;
    const int aoff = lds_byte(wr * 64 + fr, fq * 8), boff = lds_byte(wc * 32 + fr, fq * 8);
#define PG8_MKOFF(u, o) do { _Pragma("unroll") for (int _h = 0; _h < 2; ++_h) _Pragma("unroll") for (int _i = 0; _i < 2; ++_i) { int _row; \
        if (GATHER) { const int _idx = _h * 128 + R_[_i]; _row = _idx < (u).nrows ? (u).rows[_idx] : 0; } else _row = (u).arow0 + _h * 128 + R_[_i]; \
        (o).a[_h][_i] = (unsigned)(_row * (u).lda + C_[_i]) * 2u; } \
        _Pragma("unroll") for (int _i = 0; _i < 2; ++_i) (o).b[_i] = (unsigned)(Rb_[_i] * ((u).nt * 64) + C_[_i]) * 2u; } while (0)
#define PG8_SA(b, h) (((b) * 2 + (h)) * HTB)
#define PG8_SB(b, h) ((4 + (b) * 2 + (h)) * HTB)
#define PG8_GLDS(src, bufoff, i) __builtin_amdgcn_global_load_lds((const unsigned*)(src), (LAS unsigned*)(lds + (bufoff) + ldsw + (i) * 8192), 16, 0, 0)
#define PG8_STAGE_A(bufoff, AB, O, h, kb) do { _Pragma("unroll") for (int _i = 0; _i < 2; ++_i) PG8_GLDS((AB) + (kb) + (O).a[h][_i], bufoff, _i); } while (0)
#define PG8_STAGE_B(bufoff, BB, O, h, hs, kb) do { _Pragma("unroll") for (int _i = 0; _i < 2; ++_i) PG8_GLDS((BB) + (size_t)(h) * (hs) + (kb) + (O).b[_i], bufoff, _i); } while (0)
#define PG8_LDA(dst, b, h) do { _Pragma("unroll") for (int m = 0; m < 4; ++m) _Pragma("unroll") for (int k = 0; k < 2; ++k) dst[m][k] = *(const LAS bf16x8*)(lds + PG8_SA(b, h) + aoff + m * 2048 + k * 1024); } while (0)
#define PG8_LDB(dst, b, h) do { _Pragma("unroll") for (int n = 0; n < 2; ++n) _Pragma("unroll") for (int k = 0; k < 2; ++k) dst[n][k] = *(const LAS bf16x8*)(lds + PG8_SB(b, h) + boff + n * 2048 + k * 1024); } while (0)
#define PG8_MMA(ai, bj, At, Bt) do { __builtin_amdgcn_s_setprio(1); _Pragma("unroll") for (int m = 0; m < 4; ++m) _Pragma("unroll") for (int n = 0; n < 2; ++n) _Pragma("unroll") for (int k = 0; k < 2; ++k) \
        acc[ai][bj][m][n] = __builtin_amdgcn_mfma_f32_16x16x32_bf16(Bt[n][k], At[m][k], acc[ai][bj][m][n], 0, 0, 0); __builtin_amdgcn_s_setprio(0); } while (0)
#define PG8_WAIT_V(n) asm volatile("s_waitcnt vmcnt(" #n ")" ::: "memory")
#define PG8_WAIT_L(n) asm volatile("s_waitcnt lgkmcnt(" #n ")" ::: "memory")
#define PG8_BAR __builtin_amdgcn_s_barrier()
#define PG8_SCHED __builtin_amdgcn_sched_barrier(0)
    Unit cur, nxt; int ui = 0;
    if (!S.next(0, cur)) return;
    LaneOff co, no;
    PG8_MKOFF(cur, co);
    no = co;
    f32x4 acc[2][2][4][2];
#pragma unroll
    for (int a = 0; a < 2; ++a)
#pragma unroll
        for (int b = 0; b < 2; ++b)
#pragma unroll
            for (int m = 0; m < 4; ++m)
#pragma unroll
                for (int n = 0; n < 2; ++n) acc[a][b][m][n] = (f32x4){0.f, 0.f, 0.f, 0.f};
    bf16x8 At[4][2], B0[2][2], B1[2][2];
    const char* cA = cur.abase; const char* cB = cur.pb; size_t chs = (size_t)cur.nt * 16384;
    PG8_STAGE_B(PG8_SB(0, 0), cB, co, 0, chs, 0); PG8_STAGE_B(PG8_SB(0, 1), cB, co, 1, chs, 0); PG8_STAGE_A(PG8_SA(0, 0), cA, co, 0, 0); PG8_STAGE_A(PG8_SA(0, 1), cA, co, 1, 0);
    if (wr == 1) PG8_BAR;
    PG8_WAIT_V(2); PG8_BAR;
    PG8_STAGE_B(PG8_SB(1, 0), cB, co, 0, chs, 128); PG8_STAGE_A(PG8_SA(1, 0), cA, co, 0, 128); PG8_STAGE_B(PG8_SB(1, 1), cB, co, 1, chs, 128);
    PG8_WAIT_V(6); PG8_BAR;
    for (;;) {
        const bool has_next = S.next(ui + 1, nxt);
        if (has_next) PG8_MKOFF(nxt, no);
        const char* nA = has_next ? nxt.abase : cA; const char* nB = has_next ? nxt.pb : cB; const size_t nhs = has_next ? (size_t)nxt.nt * 16384 : chs;
        const int nt = cur.nt;
        for (int t = 0; t < nt; t += 2) {
            const bool last = (t == nt - 2);
            const unsigned kb1 = (unsigned)(t + 1) * 128u;
            const char* A2 = last ? nA : cA; const char* B2 = last ? nB : cB; const size_t hs2 = last ? nhs : chs;
            const unsigned kb2 = last ? 0u : (unsigned)(t + 2) * 128u, kb3 = kb2 + 128u;
            LaneOff o2;
#pragma unroll
            for (int h = 0; h < 2; ++h)
#pragma unroll
                for (int i = 0; i < 2; ++i) o2.a[h][i] = (last && has_next) ? no.a[h][i] : co.a[h][i];
#pragma unroll
            for (int i = 0; i < 2; ++i) o2.b[i] = (last && has_next) ? no.b[i] : co.b[i];
            PG8_LDB(B0, 0, 0); PG8_LDB(B1, 0, 1); PG8_SCHED; PG8_LDA(At, 0, 0); PG8_STAGE_A(PG8_SA(1, 1), cA, co, 1, kb1);
            PG8_WAIT_V(8); PG8_WAIT_L(0); PG8_BAR; PG8_MMA(0, 0, At, B0); PG8_MMA(0, 1, At, B1); PG8_BAR; PG8_SCHED;
            PG8_LDA(At, 0, 1); PG8_STAGE_B(PG8_SB(0, 0), B2, o2, 0, hs2, kb2); PG8_STAGE_B(PG8_SB(0, 1), B2, o2, 1, hs2, kb2); PG8_STAGE_A(PG8_SA(0, 0), A2, o2, 0, kb2);
            PG8_WAIT_V(8); PG8_WAIT_L(0); PG8_BAR; PG8_MMA(1, 0, At, B0); PG8_MMA(1, 1, At, B1); PG8_BAR; PG8_SCHED;
            PG8_LDB(B0, 1, 0); PG8_LDB(B1, 1, 1); PG8_SCHED; PG8_LDA(At, 1, 0); PG8_STAGE_A(PG8_SA(0, 1), A2, o2, 1, kb2);
            PG8_WAIT_V(8); PG8_WAIT_L(0); PG8_BAR; PG8_MMA(0, 0, At, B0); PG8_MMA(0, 1, At, B1); PG8_BAR; PG8_SCHED;
            PG8_LDA(At, 1, 1); PG8_STAGE_B(PG8_SB(1, 0), B2, o2, 0, hs2, kb3); PG8_STAGE_B(PG8_SB(1, 1), B2, o2, 1, hs2, kb3); PG8_STAGE_A(PG8_SA(1, 0), A2, o2, 0, kb3);
            PG8_WAIT_V(8); PG8_WAIT_L(0); PG8_BAR; PG8_MMA(1, 0, At, B0); PG8_MMA(1, 1, At, B1); PG8_BAR; PG8_SCHED;
        }
        if (wr == 0) PG8_BAR;
        E(acc, cur, wr, wc, fr, fq, tid);
        if (!has_next) break;
#pragma unroll
        for (int a = 0; a < 2; ++a)
#pragma unroll
            for (int b = 0; b < 2; ++b)
#pragma unroll
                for (int m = 0; m < 4; ++m)
#pragma unroll
                    for (int n = 0; n < 2; ++n) acc[a][b][m][n] = (f32x4){0.f, 0.f, 0.f, 0.f};
        cur = nxt; cA = nA; cB = nB; chs = nhs; co = no; ++ui;
        if (wr == 1) PG8_BAR;
    }
    PG8_WAIT_V(0);
    PG8_BAR;
#undef PG8_MKOFF
#undef PG8_SA
#undef PG8_SB
#undef PG8_GLDS
#undef PG8_STAGE_A
#undef PG8_STAGE_B
#undef PG8_LDA
#undef PG8_LDB
#undef PG8_MMA
#undef PG8_WAIT_V
#undef PG8_WAIT_L
#undef PG8_BAR
#undef PG8_SCHED
}

typedef const f32x4 (&AccRef)[2][2][4][2];
__device__ __forceinline__ u32x4 pack8(const f32x4 v0, const f32x4 v1) { u32x4 w; w.x = cvt_pk_bf16(v0[0], v0[1]); w.y = cvt_pk_bf16(v0[2], v0[3]); w.z = cvt_pk_bf16(v1[0], v1[1]); w.w = cvt_pk_bf16(v1[2], v1[3]); return w; }

struct EpiP {
    static constexpr bool PERM = true;
    bf16* P; bf16* KB; bf16* VT;
    __device__ __forceinline__ void operator()(AccRef acc, const Unit& u, int wr, int wc, int fr, int fq, int tid) const {
        if (u.sub == 0) {
            const int row0 = u.pm * BM + wr * 64 + fr, col0 = u.pn * BM + wc * 32 + 8 * fq;
#pragma unroll
            for (int ai = 0; ai < 2; ++ai)
#pragma unroll
                for (int m = 0; m < 4; ++m) { bf16* rowp = P + (size_t)(row0 + ai * HALF + m * 16) * NINX + col0;
#pragma unroll
                    for (int bj = 0; bj < 2; ++bj) *(u32x4*)(rowp + bj * HALF) = pack8(acc[ai][bj][m][0], acc[ai][bj][m][1]); }
        } else {
#pragma unroll
            for (int ai = 0; ai < 2; ++ai)
#pragma unroll
                for (int m = 0; m < 4; ++m) { const int row = u.pm * BM + ai * HALF + wr * 64 + m * 16 + fr;
#pragma unroll
                    for (int bj = 0; bj < 2; ++bj)
#pragma unroll
                        for (int n = 0; n < 2; ++n)
#pragma unroll
                            for (int e = 0; e < 4; ++e) { const int col = u.pn * BM + bj * HALF + wc * 32 + 8 * fq + 4 * n + e; const bf16 v = (bf16)f2bf(acc[ai][bj][m][n][e]);
                                if (col < 512) KB[(size_t)row * 512 + col] = v;
                                else { const int c2 = col - 512, hd = c2 >> 7, d = c2 & 127, b = row >> 8, key = row & 255; VT[((size_t)(b * 4 + hd) * 128 + d) * 256 + key] = v; } } }
        }
    }
};
struct EpiMerge {
    static constexpr bool PERM = true;
    const float* bgate; bf16* Gs; bf16* Z;
    __device__ __forceinline__ void operator()(AccRef acc, const Unit& u, int wr, int wc, int fr, int fq, int tid) const {
        const int br = u.sub >> 1; const int col0 = u.pn * BM + wc * 32 + 8 * fq;
        int t2 = tid; asm volatile("" : "+v"(t2));
        bf16* gsp = Gs + (size_t)(t2 >> 3) * 1024 + (t2 & 7) * 8;
        if ((u.sub & 1) == 0) {
            f32x4 bv[2][2];
#pragma unroll
            for (int bj = 0; bj < 2; ++bj)
#pragma unroll
                for (int n = 0; n < 2; ++n) bv[bj][n] = *(const f32x4*)(bgate + br * 1024 + col0 + bj * HALF + 4 * n);
#pragma unroll
            for (int ai = 0; ai < 2; ++ai)
#pragma unroll
                for (int m = 0; m < 4; ++m)
#pragma unroll
                    for (int bj = 0; bj < 2; ++bj) { f32x4 v0 = acc[ai][bj][m][0] + bv[bj][0], v1 = acc[ai][bj][m][1] + bv[bj][1];
#pragma unroll
                        for (int e = 0; e < 4; ++e) { v0[e] = sigmoidf_(v0[e]); v1[e] = sigmoidf_(v1[e]); }
                        *(u32x4*)(gsp + ((ai * 4 + m) * 2 + bj) * 64) = pack8(v0, v1); }
        } else {
            const int row0 = u.pm * BM + wr * 64 + fr;
#pragma unroll
            for (int ai = 0; ai < 2; ++ai)
#pragma unroll
                for (int m = 0; m < 4; ++m) { bf16* zrow = Z + (size_t)(row0 + ai * HALF + m * 16) * 1024 + col0;
#pragma unroll
                    for (int bj = 0; bj < 2; ++bj) { const u32x4 g = *(const u32x4*)(gsp + ((ai * 4 + m) * 2 + bj) * 64);
                        f32x4 v0 = acc[ai][bj][m][0], v1 = acc[ai][bj][m][1];
                        v0[0] *= bflo(g.x); v0[1] *= bfhi(g.x); v0[2] *= bflo(g.y); v0[3] *= bfhi(g.y); v1[0] *= bflo(g.z); v1[1] *= bfhi(g.z); v1[2] *= bflo(g.w); v1[3] *= bfhi(g.w);
                        if (br > 0) { const u32x4 z = *(const u32x4*)(zrow + bj * HALF);
                            v0[0] += bflo(z.x); v0[1] += bfhi(z.x); v0[2] += bflo(z.y); v0[3] += bfhi(z.y); v1[0] += bflo(z.z); v1[1] += bfhi(z.z); v1[2] += bflo(z.w); v1[3] += bfhi(z.w); }
                        *(u32x4*)(zrow + bj * HALF) = pack8(v0, v1); } }
        }
    }
};
struct EpiX2 {
    static constexpr bool PERM = false;
    const float* x; float* out;
    __device__ __forceinline__ void operator()(AccRef acc, const Unit& u, int wr, int wc, int fr, int fq, int tid) const {
        const int row0 = u.pm * BM + wr * 64 + fr, col0 = u.pn * BM + wc * 32 + 4 * fq;
#pragma unroll
        for (int ai = 0; ai < 2; ++ai)
#pragma unroll
            for (int m = 0; m < 4; ++m) { const size_t off = (size_t)(row0 + ai * HALF + m * 16) * 1024 + col0;
#pragma unroll
                for (int bj = 0; bj < 2; ++bj)
#pragma unroll
                    for (int n = 0; n < 2; ++n) *(f32x4*)(out + off + bj * HALF + n * 16) = *(const f32x4*)(x + off + bj * HALF + n * 16) + acc[ai][bj][m][n]; }
    }
};
struct EpiHid {
    static constexpr bool PERM = true;
    bf16* HID;
    __device__ __forceinline__ void operator()(AccRef acc, const Unit& u, int wr, int wc, int fr, int fq, int tid) const {
        const int row0 = u.pm * BM + wr * 64 + fr, col0 = u.pn * HALF + wc * 32 + 8 * fq;
#pragma unroll
        for (int ai = 0; ai < 2; ++ai)
#pragma unroll
            for (int m = 0; m < 4; ++m) { f32x4 v0, v1;
#pragma unroll
                for (int e = 0; e < 4; ++e) { const float g0 = acc[ai][0][m][0][e], g1 = acc[ai][0][m][1][e]; v0[e] = g0 * sigmoidf_(g0) * acc[ai][1][m][0][e]; v1[e] = g1 * sigmoidf_(g1) * acc[ai][1][m][1][e]; }
                *(u32x4*)(HID + (size_t)(row0 + ai * HALF + m * 16) * DEXP + col0) = pack8(v0, v1); }
    }
};
struct EpiY {
    static constexpr bool PERM = true;
    bf16* Y;
    __device__ __forceinline__ void operator()(AccRef acc, const Unit& u, int wr, int wc, int fr, int fq, int tid) const {
        const int row0 = u.pm * BM + wr * 64 + fr, col0 = u.pn * BM + wc * 32 + 8 * fq;
#pragma unroll
        for (int ai = 0; ai < 2; ++ai)
#pragma unroll
            for (int m = 0; m < 4; ++m) { bf16* rowp = Y + (size_t)(row0 + ai * HALF + m * 16) * 1024 + col0;
#pragma unroll
                for (int bj = 0; bj < 2; ++bj) *(u32x4*)(rowp + bj * HALF) = pack8(acc[ai][bj][m][0], acc[ai][bj][m][1]); }
    }
};

struct SchedP1 {
    int G, c; const char *H, *MEMN, *WIN, *WKV; bool kvonly;
    __device__ __forceinline__ bool next(int i, Unit& u) const {
        int L = i * G + c;
        if (kvonly) { if (i > 0 || c >= 8) return false; const int pm = c >> 2, pn = c & 3; u.pm = pm; u.pn = pn; u.sub = 1; u.nt = 16; u.lda = 1024; u.arow0 = pm * 256; u.nrows = 0; u.abase = MEMN; u.pb = WKV + (size_t)pn * 256 * 2048; u.rows = nullptr; return true; }
        if (L < 1024) { int pm, pn; tile_map(L, 64, 16, pm, pn); u.pm = pm; u.pn = pn; u.sub = 0; u.nt = 16; u.lda = 1024; u.arow0 = pm * 256; u.nrows = 0; u.abase = H; u.pb = WIN + (size_t)pn * 256 * 2048; u.rows = nullptr; return true; }
        return false;
    }
};
struct SchedMerge {
    int G, c; const char *H, *YB, *WGT, *WBR;
    __device__ __forceinline__ bool next(int i, Unit& u) const {
        const int k = i / 6, sub = i - 6 * k; const int L = k * G + c; if (L >= 256) return false;
        int pm, pn; tile_map(L, 64, 4, pm, pn); const int br = sub >> 1;
        u.pm = pm; u.pn = pn; u.sub = sub; u.arow0 = pm * 256; u.nrows = 0; u.rows = nullptr;
        if ((sub & 1) == 0) { u.nt = 16; u.lda = 1024; u.abase = H; u.pb = WGT + ((size_t)(br * 1024 + pn * 256)) * 2048; }
        else { u.nt = 8; u.lda = 512; u.abase = YB + (size_t)br * T * 1024; u.pb = WBR + ((size_t)(br * 1024 + pn * 256)) * 1024; }
        return true;
    }
};
struct SchedX2 {
    int G, c; const char *Z, *WO;
    __device__ __forceinline__ bool next(int i, Unit& u) const {
        const int L = i * G + c; if (L >= 256) return false;
        int pm, pn; tile_map(L, 64, 4, pm, pn);
        u.pm = pm; u.pn = pn; u.sub = 0; u.nt = 16; u.lda = 1024; u.arow0 = pm * 256; u.nrows = 0; u.rows = nullptr; u.abase = Z; u.pb = WO + (size_t)pn * 256 * 2048; return true;
    }
};
constexpr int MOE_MAXU = 8;
struct SchedMoe {
    const volatile LAS int* tab; int phase;
    const char *H2, *HID, *W1, *W2; const int* LIST;
    __device__ __forceinline__ bool next(int i, Unit& u) const {
        if (i >= MOE_MAXU) return false;
        const int e = tab[136 + 4 * i]; if (e < 0) return false;
        const int gt = tab[136 + 4 * i + 1], pn = tab[136 + 4 * i + 2], rt = tab[136 + 4 * i + 3];
        u.pm = gt; u.pn = pn; u.sub = e;
        if (phase == 1) { u.nt = 16; u.lda = 1024; u.arow0 = 0; u.abase = H2; u.rows = LIST + (size_t)e * T + rt * 256; const int c = tab[e] - rt * 256; u.nrows = c < 256 ? c : 256; u.pb = W1 + ((size_t)e * 1024 + pn * 256) * 2048; }
        else { u.nt = 8; u.lda = 512; u.arow0 = gt * 256; u.abase = HID; u.rows = nullptr; u.nrows = 0; u.pb = W2 + ((size_t)e * 1024 + pn * 256) * 1024; }
        return true;
    }
};
}

#define XB_TMO      128
#define XB_XCNT(j)  (256  + 64 * (j))
#define XB_XSUB(j)  (1280 + 64 * (j))
#define XB_XGEN(j)  (2304 + 64 * (j))
#define XB_TOP      3328
#define XB_TOPGEN   3392
#define XCD_BAR_WORDS 3456
#define XB_SPIN_CAP (1u << 18)
__device__ __forceinline__ unsigned xb_ld(unsigned* p)              { return __hip_atomic_load(p, __ATOMIC_RELAXED, __HIP_MEMORY_SCOPE_AGENT); }
__device__ __forceinline__ unsigned xb_add(unsigned* p, unsigned v) { return __hip_atomic_fetch_add(p, v, __ATOMIC_RELAXED, __HIP_MEMORY_SCOPE_AGENT); }
__device__ __forceinline__ unsigned xb_xcc_id() { return (unsigned)__builtin_amdgcn_s_getreg((3 << 11) | 20) & 0xFu; }
#define XB_SPIN(cond, bar) do { unsigned _sp = 0; while (cond) { __builtin_amdgcn_s_sleep(1); \
    if ((++_sp & 255u) == 0u) { if (xb_ld(&(bar)[XB_TMO])) break; if (_sp > XB_SPIN_CAP) { atomicAdd(&(bar)[XB_TMO], 1u); break; } } } } while (0)
struct XcdBarrier { unsigned* bar; unsigned x; volatile LAS unsigned* st; };
__device__ __forceinline__ XcdBarrier xcd_barrier_post(unsigned* bar, volatile LAS unsigned* st) {
    XcdBarrier b; b.bar = bar; b.x = xb_xcc_id(); b.st = st;
    if (threadIdx.x == 0) (void)xb_add(&bar[XB_XCNT(b.x)], 1u);
    return b;
}
__device__ __forceinline__ void xcd_barrier_complete(unsigned* bar, unsigned x, unsigned& nloc, unsigned& nx) {
    const unsigned G = gridDim.x * gridDim.y * gridDim.z;
    unsigned sum, cnt, mine, sp = 0u;
    for (;;) {
        sum = 0u; cnt = 0u; mine = 0u;
#pragma unroll
        for (unsigned j = 0; j < 16; ++j) { const unsigned c = xb_ld(&bar[XB_XCNT(j)]); sum += c; cnt += (c > 0u) ? 1u : 0u; mine = (j == x) ? c : mine; }
        if (sum == G) break;
        __builtin_amdgcn_s_sleep(1);
        if ((++sp & 255u) == 0u) { if (xb_ld(&bar[XB_TMO])) break; if (sp > XB_SPIN_CAP) { atomicAdd(&bar[XB_TMO], 1u); break; } }
    }
    nloc = mine > 0u ? mine : 1u; nx = cnt > 0u ? cnt : 1u;
}
__device__ __forceinline__ void xcd_barrier(const XcdBarrier& b) {
    asm volatile("s_waitcnt vmcnt(0)" ::: "memory");
    __syncthreads();
    if (threadIdx.x == 0) {
        unsigned* bar = b.bar;
        __builtin_amdgcn_s_waitcnt(0);
        unsigned nloc = b.st[0], nx = b.st[1];
        if (nloc == 0u) { xcd_barrier_complete(bar, b.x, nloc, nx); b.st[0] = nloc; b.st[1] = nx; }
        const unsigned old = xb_add(&bar[XB_XSUB(b.x)], 1u);
        const unsigned gen = old / nloc;
        if (old + 1u == (gen + 1u) * nloc) {
            __builtin_amdgcn_fence(__ATOMIC_RELEASE, "agent");
            asm volatile("s_waitcnt vmcnt(0)" ::: "memory");
            const unsigned og = xb_add(&bar[XB_TOP], 1u);
            const unsigned tg = og / nx;
            if (og + 1u == (tg + 1u) * nx) xb_add(&bar[XB_TOPGEN], 1u);
            else XB_SPIN(xb_ld(&bar[XB_TOPGEN]) == tg, bar);
            __builtin_amdgcn_fence(__ATOMIC_ACQUIRE, "agent");
            xb_add(&bar[XB_XGEN(b.x)], 1u);
            asm volatile("s_waitcnt vmcnt(0)" ::: "memory");
        } else {
            XB_SPIN(xb_ld(&bar[XB_XGEN(b.x)]) == gen, bar);
            __builtin_amdgcn_fence(__ATOMIC_ACQUIRE, "agent");
            asm volatile("s_waitcnt vmcnt(0)" ::: "memory");
        }
    }
    __syncthreads();
}

constexpr int NWAVES = 8;
struct Args { const float* in[35]; float* out; unsigned char* ws; int ph_lo, ph_hi; };
struct Frame {
    LAS unsigned char* lds;
    volatile LAS unsigned* MISC;
    gu32* ctl;
    int tid, lane, wave, vcu, G;
    float* out; unsigned char* ws;
};

__device__ __forceinline__ void transpose_item(const float* W, int ldw, int K, int k0, int n0, bf16* WT, int drow0, const float* sc, int mode, LAS float* scr, int lane) {
    const int n4 = (lane & 7) * 4, kq = lane >> 3;
    f32x4 v[8];
#pragma unroll
    for (int i = 0; i < 8; ++i) v[i] = *(const GAS f32x4*)(W + (size_t)(k0 + 8 * i + kq) * ldw + n0 + n4);
#pragma unroll
    for (int i = 0; i < 8; ++i) { const int kk = 8 * i + kq; f32x4 x = v[i];
        if (mode) { const float s = sc[k0 + kk]; x = x * ((mode == 1) ? s : (1.0f - s)); }
        LAS float* d = scr + kk * 33 + n4; d[0] = x.x; d[1] = x.y; d[2] = x.z; d[3] = x.w; }
    LDS_WAIT(); asm volatile("" ::: "memory");
    const int c = lane & 7;
#pragma unroll
    for (int j = 0; j < 4; ++j) { const int n = (lane >> 3) + 8 * j; const LAS float* s = scr + (8 * c) * 33 + n;
        u32x4 o; o.x = pk2(s[0 * 33], s[1 * 33]); o.y = pk2(s[2 * 33], s[3 * 33]); o.z = pk2(s[4 * 33], s[5 * 33]); o.w = pk2(s[6 * 33], s[7 * 33]);
        *(GAS u32x4*)(WT + (size_t)(drow0 + n) * K + k0 + 8 * c) = o; }
    LDS_WAIT(); asm volatile("" ::: "memory");
}
__device__ __forceinline__ void rms_row_to_bf16(const float* xrow, const float* g, bf16* orow, int lane) {
    const GAS f32x4* xr = (const GAS f32x4*)xrow + lane; const GAS f32x4* gr = (const GAS f32x4*)g + lane;
    f32x4 v[4]; float s = 0.f;
#pragma unroll
    for (int j = 0; j < 4; ++j) { v[j] = xr[64 * j]; s += (v[j].x * v[j].x + v[j].y * v[j].y) + (v[j].z * v[j].z + v[j].w * v[j].w); }
    const float rinv = 1.0f / sqrtf(wave_sum(s) * (1.f / D) + NORM_EPS);
    GAS unsigned long long* o8 = (GAS unsigned long long*)orow + lane;
#pragma unroll
    for (int j = 0; j < 4; ++j) { const f32x4 gv = gr[64 * j]; const f32x4 o = v[j] * rinv * gv; o8[64 * j] = (unsigned long long)pk2(o.x, o.y) | ((unsigned long long)pk2(o.z, o.w) << 32); }
}

__device__ __forceinline__ void p0_prologue(Frame& F, const Args& A) {
    LAS float* scr = (LAS float*)(F.lds + F.wave * 16384);
    const int gw = F.vcu * NWAVES + F.wave, NGW = F.G * NWAVES;
    bf16* WIN = (bf16*)(F.ws + WS_WIN); bf16* WGT = (bf16*)(F.ws + WS_WGATE); bf16* WBR = (bf16*)(F.ws + WS_WBR); bf16* WO = (bf16*)(F.ws + WS_WO); bf16* WKV = (bf16*)(F.ws + WS_WKV);
    constexpr int I_IN = 16 * 112, I_LO = 16 * 8, I_G = 16 * 96, I_BR = 8 * 32, I_O = 16 * 32, I_KV = 16 * 32;
    constexpr int NITEMS = I_IN + 2 * I_LO + I_G + 3 * I_BR + I_O + I_KV;
    for (int it = gw; it < NITEMS; it += NGW) {
        int r = it;
        if (r < I_IN) { const int kb = r / 112, nb = r % 112; transpose_item(A.in[4], 3584, 1024, 64 * kb, 32 * nb, WIN, 32 * nb, nullptr, 0, scr, F.lane); continue; } r -= I_IN;
        if (r < 2 * I_LO) { const int part = r / I_LO; r -= part * I_LO; const int kb = r / 8, nb = r % 8;
            const int n = 32 * nb; const float* W; int ldw, nn, mu;
            if (n < 64) { W = A.in[8]; ldw = 64; nn = n; mu = 0; } else if (n < 128) { W = A.in[11]; ldw = 64; nn = n - 64; mu = 1; } else { W = A.in[14]; ldw = 128; nn = n - 128; mu = 2; }
            transpose_item(W, ldw, 1024, 64 * kb, nn, WIN, (part == 0 ? C_LA : C_LB) + n, A.in[7] + mu * 1024, part == 0 ? 2 : 1, scr, F.lane); continue; } r -= 2 * I_LO;
        if (r < I_G) { const int kb = r / 96, nb = r % 96; transpose_item(A.in[23], 3072, 1024, 64 * kb, 32 * nb, WGT, 32 * nb, nullptr, 0, scr, F.lane); continue; } r -= I_G;
        if (r < 3 * I_BR) { const int br = r / I_BR; r -= br * I_BR; const int kb = r / 32, nb = r % 32; transpose_item(A.in[22] + (size_t)br * 512 * 1024, 1024, 512, 64 * kb, 32 * nb, WBR + (size_t)br * 1024 * 512, 32 * nb, nullptr, 0, scr, F.lane); continue; } r -= 3 * I_BR;
        if (r < I_O) { const int kb = r / 32, nb = r % 32; transpose_item(A.in[25], 1024, 1024, 64 * kb, 32 * nb, WO, 32 * nb, nullptr, 0, scr, F.lane); continue; } r -= I_O;
        { const int kb = r / 32, nb = r % 32; transpose_item(A.in[21], 1024, 1024, 64 * kb, 32 * nb, WKV, 32 * nb, nullptr, 0, scr, F.lane); }
    }
    for (int it = gw; it < 64; it += NGW) {
        if (it < 16) transpose_item(A.in[9], 512, 64, 0, 32 * it, (bf16*)(F.ws + WS_W2T), 32 * it, nullptr, 0, scr, F.lane);
        else if (it < 32) transpose_item(A.in[12], 512, 64, 0, 32 * (it - 16), (bf16*)(F.ws + WS_A2T), 32 * (it - 16), nullptr, 0, scr, F.lane);
        else { const int r2 = it - 32; transpose_item(A.in[15], 512, 128, 64 * (r2 >> 4), 32 * (r2 & 15), (bf16*)(F.ws + WS_G2T), 32 * (r2 & 15), nullptr, 0, scr, F.lane); } }
    { bf16* RH = (bf16*)(F.ws + WS_RTHI); bf16* RL = (bf16*)(F.ws + WS_RTLO);
      for (int idx = (F.vcu * NWAVES + F.wave) * 64 + F.lane; idx < 80 * 1024; idx += NGW * 64) { const int n = idx >> 10, k = idx & 1023;
          float w = 0.f; if (n < 8) w = A.in[27][k * 8 + n]; else if (n < 72) w = A.in[29][k * 64 + (n - 8)];
          const unsigned hi = f2bf(w); const float lo = w - bf2f(hi); RH[idx] = (bf16)hi; RL[idx] = (bf16)f2bf(lo); } }
    bf16* H = (bf16*)(F.ws + WS_H); bf16* MEMN = (bf16*)(F.ws + WS_MEMN);
    for (int m = gw; m < T; m += NGW) rms_row_to_bf16(A.in[0] + (size_t)m * D, A.in[2], H + (size_t)m * D, F.lane);
    for (int m = gw; m < NB * MEML; m += NGW) rms_row_to_bf16(A.in[1] + (size_t)m * D, A.in[3], MEMN + (size_t)m * D, F.lane);
}

__device__ __forceinline__ void convert_experts(Frame& F, const Args& A, int gw, int NGW) {
    LAS float* scr = (LAS float*)(F.lds + F.wave * 16384);
    bf16* E1 = (bf16*)(F.ws + WS_E1); bf16* E2 = (bf16*)(F.ws + WS_E2);
    constexpr int PER_E = 256;
    for (int it = gw; it < 3 * NEXP * PER_E; it += NGW) {
        const int mat = it / (NEXP * PER_E); int r = it - mat * (NEXP * PER_E); const int e = r / PER_E; r -= e * PER_E;
        if (mat < 2) { const int kb = r / 16, nb = r % 16, n = 32 * nb;
            transpose_item(A.in[31 + mat] + (size_t)e * 1024 * 512, 512, 1024, 64 * kb, n, E1 + (size_t)e * 1024 * 1024, (n >> 7) * 256 + mat * 128 + (n & 127), nullptr, 0, scr, F.lane); }
        else { const int kb = r / 32, nb = r % 32;
            transpose_item(A.in[33] + (size_t)e * 512 * 1024, 1024, 512, 64 * kb, 32 * nb, E2 + (size_t)e * 1024 * 512, 32 * nb, nullptr, 0, scr, F.lane); }
    }
}

__device__ __forceinline__ void mem_attn_unit(Frame& F, int unit) {
    const bf16* P = (const bf16*)(F.ws + WS_P); const bf16* KB = (const bf16*)(F.ws + WS_KB); const bf16* VT = (const bf16*)(F.ws + WS_VT); bf16* Y = (bf16*)(F.ws + WS_YB) + (size_t)2 * T * DB;
    const int b = unit >> 7, hd = (unit >> 5) & 3, qb = unit & 31;
    const int t0 = b * SEQ + qb * 256 + F.wave * 32, rr = F.lane & 31, h = F.lane >> 5;
    bf16x8 qf[8];
    { const bf16* qrow = P + (size_t)(t0 + rr) * NINX + C_Q + hd * 128 + 8 * h;
#pragma unroll
      for (int ks = 0; ks < 8; ++ks) qf[ks] = *(const GAS bf16x8*)(qrow + 16 * ks); }
    f32x16 s[8];
    const bf16* kbase = KB + (size_t)(b * 256 + rr) * 512 + hd * 128 + 8 * h;
#pragma unroll
    for (int kt = 0; kt < 8; ++kt) { f32x16 a = {0.f, 0.f, 0.f, 0.f, 0.f, 0.f, 0.f, 0.f, 0.f, 0.f, 0.f, 0.f, 0.f, 0.f, 0.f, 0.f};
#pragma unroll
        for (int ks = 0; ks < 8; ++ks) { const bf16x8 kf = *(const GAS bf16x8*)(kbase + (size_t)kt * 32 * 512 + 16 * ks); a = __builtin_amdgcn_mfma_f32_32x32x16_bf16(kf, qf[ks], a, 0, 0, 0); }
        s[kt] = a; }
    float mx = -3.0e38f;
#pragma unroll
    for (int kt = 0; kt < 8; ++kt)
#pragma unroll
        for (int r = 0; r < 16; ++r) mx = fmaxf(mx, s[kt][r]);
    mx = fmaxf(mx, __shfl_xor(mx, 32));
    const float sc = 0.08838834764831845f * 1.4426950408889634f; float sum = 0.f;
#pragma unroll
    for (int kt = 0; kt < 8; ++kt)
#pragma unroll
        for (int r = 0; r < 16; ++r) { const float p = exp2f((s[kt][r] - mx) * sc); s[kt][r] = p; sum += p; }
    sum += __shfl_xor(sum, 32);
    const float inv = 1.0f / sum;
    f32x16 o[4];
#pragma unroll
    for (int dt = 0; dt < 4; ++dt) o[dt] = (f32x16){0.f, 0.f, 0.f, 0.f, 0.f, 0.f, 0.f, 0.f, 0.f, 0.f, 0.f, 0.f, 0.f, 0.f, 0.f, 0.f};
    const bf16* vbase = VT + ((size_t)(b * 4 + hd) * 128 + rr) * 256 + 4 * h;
#pragma unroll
    for (int kt = 0; kt < 8; ++kt)
#pragma unroll
        for (int sp = 0; sp < 2; ++sp) {
            u32x4 pw; pw.x = cvt_pk_bf16(s[kt][8 * sp + 0], s[kt][8 * sp + 1]); pw.y = cvt_pk_bf16(s[kt][8 * sp + 2], s[kt][8 * sp + 3]); pw.z = cvt_pk_bf16(s[kt][8 * sp + 4], s[kt][8 * sp + 5]); pw.w = cvt_pk_bf16(s[kt][8 * sp + 6], s[kt][8 * sp + 7]);
            const bf16x8 pb = __builtin_bit_cast(bf16x8, pw);
#pragma unroll
            for (int dt = 0; dt < 4; ++dt) { const bf16* vp = vbase + (size_t)dt * 32 * 256 + 32 * kt + 16 * sp;
                const u32x2 lo = *(const GAS u32x2*)(vp), hi = *(const GAS u32x2*)(vp + 8);
                const u32x4 vw = {lo.x, lo.y, hi.x, hi.y};
                o[dt] = __builtin_amdgcn_mfma_f32_32x32x16_bf16(__builtin_bit_cast(bf16x8, vw), pb, o[dt], 0, 0, 0); } }
    bf16* yrow = Y + (size_t)(t0 + rr) * DB + hd * 128 + 4 * h;
#pragma unroll
    for (int dt = 0; dt < 4; ++dt)
#pragma unroll
        for (int g = 0; g < 4; ++g) { u32x2 w; w.x = cvt_pk_bf16(o[dt][4 * g] * inv, o[dt][4 * g + 1] * inv); w.y = cvt_pk_bf16(o[dt][4 * g + 2] * inv, o[dt][4 * g + 3] * inv);
            *(GAS u32x2*)(yrow + 32 * dt + 8 * g) = w; }
}

__device__ __forceinline__ void conv_job(Frame& F, const Args& A, int job) {
    const bf16* P = (const bf16*)(F.ws + WS_P); bf16* Y = (bf16*)(F.ws + WS_YB);
    int tid_ = F.tid; asm volatile("" : "+v"(tid_));
    const int c0 = (tid_ & 63) * 8, tr = tid_ >> 6, t0 = job * 64;
    float w[8][3];
#pragma unroll
    for (int e = 0; e < 8; ++e)
#pragma unroll
        for (int j = 0; j < 3; ++j) w[e][j] = A.in[5][(c0 + e) * 3 + j];
#pragma unroll 2
    for (int ps = 0; ps < 8; ++ps) { const int t = t0 + ps * 8 + tr, ts = t & (SEQ - 1); const bf16* p = P + (size_t)t * NINX + c0;
        const u32x4 zz = {0u, 0u, 0u, 0u};
        const u32x4 bg = *(const GAS u32x4*)(p + C_BG), g0 = *(const GAS u32x4*)(p + C_CG), u0 = *(const GAS u32x4*)(p + C_U);
        u32x4 g1 = zz, u1 = zz, g2 = zz, u2 = zz;
        if (ts >= 1) { g1 = *(const GAS u32x4*)(p - NINX + C_CG); u1 = *(const GAS u32x4*)(p - NINX + C_U); }
        if (ts >= 2) { g2 = *(const GAS u32x4*)(p - 2 * NINX + C_CG); u2 = *(const GAS u32x4*)(p - 2 * NINX + C_U); }
        float o[8];
#define CV(e, W) { const unsigned sh = ((e) & 1) ? 0u : 16u; const float b_ = __builtin_bit_cast(float, ((e) & 1) ? (bg.W & 0xffff0000u) : (bg.W << 16)); \
            const float c0_ = __builtin_bit_cast(float, ((e) & 1) ? (g0.W & 0xffff0000u) : (g0.W << 16)) * __builtin_bit_cast(float, ((e) & 1) ? (u0.W & 0xffff0000u) : (u0.W << 16)); \
            const float c1_ = __builtin_bit_cast(float, ((e) & 1) ? (g1.W & 0xffff0000u) : (g1.W << 16)) * __builtin_bit_cast(float, ((e) & 1) ? (u1.W & 0xffff0000u) : (u1.W << 16)); \
            const float c2_ = __builtin_bit_cast(float, ((e) & 1) ? (g2.W & 0xffff0000u) : (g2.W << 16)) * __builtin_bit_cast(float, ((e) & 1) ? (u2.W & 0xffff0000u) : (u2.W << 16)); \
            (void)sh; o[e] = b_ * (w[e][0] * c2_ + w[e][1] * c1_ + w[e][2] * c0_); }
        CV(0, x) CV(1, x) CV(2, y) CV(3, y) CV(4, z) CV(5, z) CV(6, w) CV(7, w)
#undef CV
        *(GAS u32x4*)(Y + (size_t)t * DB + c0) = (u32x4){cvt_pk_bf16(o[0], o[1]), cvt_pk_bf16(o[2], o[3]), cvt_pk_bf16(o[4], o[5]), cvt_pk_bf16(o[6], o[7])}; }
}

__device__ __forceinline__ void rwkv_prep_naive(Frame& F, const Args& A, int job) {
    const bf16* P = (const bf16*)(F.ws + WS_P);
    float* NW = (float*)(F.ws + WS_NV); float* NKK = NW + (size_t)T * DB; float* NBB = NKK + (size_t)T * DB; float* NKM = NBB + (size_t)T * DB; float* NVV = NKM + (size_t)T * DB; float* NR = NVV + (size_t)T * DB;
    bf16* GG = (bf16*)(F.ws + WS_GG); float* CB = (float*)(F.ws + WS_CB);
    LAS float* act = (LAS float*)F.lds;
    const int c = F.tid, hd = c >> 6;
    const float mu_r = A.in[6][c], mu_k = A.in[6][512 + c], mu_v = A.in[6][1024 + c];
    const float w0c = A.in[10][c], a0c = A.in[13][c], kkc = A.in[16][c], kac = A.in[17][c], rkc = A.in[18][c];
    for (int blk = 0; blk < 8; ++blk) {
        const int tb = job * 64 + blk * 8;
        if (c < 256) {
#pragma unroll
            for (int tk = 0; tk < 8; ++tk) { const int t = tb + tk; float v = bf2f(P[(size_t)t * NINX + C_LA + c]); if ((t & (SEQ - 1)) != 0) v += bf2f(P[(size_t)(t - 1) * NINX + C_LB + c]);
                if (c < 64) v = tanhf(v); else if (c >= 128) v = sigmoidf_(v);
                act[c * 8 + tk] = v; }
        }
        __syncthreads();
        float dw[8], da[8], dg[8];
#pragma unroll
        for (int k = 0; k < 8; ++k) { dw[k] = 0.f; da[k] = 0.f; dg[k] = 0.f; }
        for (int n = 0; n < 64; ++n) { const float wv = A.in[9][n * 512 + c], av = A.in[12][n * 512 + c];
            const f32x4 x0 = *(const LAS f32x4*)(act + n * 8), x1 = *(const LAS f32x4*)(act + n * 8 + 4), y0 = *(const LAS f32x4*)(act + (64 + n) * 8), y1 = *(const LAS f32x4*)(act + (64 + n) * 8 + 4);
#pragma unroll
            for (int k = 0; k < 4; ++k) { dw[k] += x0[k] * wv; dw[4 + k] += x1[k] * wv; da[k] += y0[k] * av; da[4 + k] += y1[k] * av; } }
        for (int n = 0; n < 128; ++n) { const float gv = A.in[15][n * 512 + c];
            const f32x4 x0 = *(const LAS f32x4*)(act + (128 + n) * 8), x1 = *(const LAS f32x4*)(act + (128 + n) * 8 + 4);
#pragma unroll
            for (int k = 0; k < 4; ++k) { dg[k] += x0[k] * gv; dg[4 + k] += x1[k] * gv; } }
        float rp_p = 0.f, kp_p = 0.f, vp_p = 0.f;
        if ((tb & (SEQ - 1)) != 0) { const bf16* pp = P + (size_t)(tb - 1) * NINX; rp_p = bf2f(pp[C_RP + c]); kp_p = bf2f(pp[C_KP + c]); vp_p = bf2f(pp[C_VP + c]); }
#pragma unroll
        for (int tk = 0; tk < 8; ++tk) { const int t = tb + tk; const bf16* p = P + (size_t)t * NINX;
            const float rp = bf2f(p[C_RP + c]), kp = bf2f(p[C_KP + c]), vp = bf2f(p[C_VP + c]);
            const float r = rp + (rp_p - rp) * mu_r, k = kp + (kp_p - kp) * mu_k, v = vp + (vp_p - vp) * mu_v;
            rp_p = rp; kp_p = kp; vp_p = vp;
            const float xw = -(w0c + dw[tk]); const float sp = fmaxf(xw, 0.f) + log1pf(__expf(-fabsf(xw)));
            const float wl = -sp - 0.5f; const float decay = __expf(-__expf(wl));
            const float a = sigmoidf_(a0c + da[tk]);
            const float kkv = k * kkc; const float n2 = wave_sum(kkv * kkv); const float kk = kkv * (1.0f / sqrtf(fmaxf(n2, 1e-24f)));
            const float km = k * (1.f + (a - 1.f) * kac);
            const float cb = wave_sum(r * km * rkc);
            const size_t o = (size_t)t * DB + c;
            NW[o] = decay; NKK[o] = kk; NBB[o] = kk * a; NKM[o] = km; NVV[o] = v; NR[o] = r; GG[o] = (bf16)f2bf(dg[tk]);
            if (F.lane == 0) CB[(size_t)t * 8 + hd] = cb; }
        __syncthreads();
    }
}
__device__ __forceinline__ void rwkv_scan_naive(Frame& F, const Args& A, int chain) {
    const float* NW = (const float*)(F.ws + WS_NV); const float* NKK = NW + (size_t)T * DB; const float* NBB = NKK + (size_t)T * DB; const float* NKM = NBB + (size_t)T * DB; const float* NVV = NKM + (size_t)T * DB; const float* NR = NVV + (size_t)T * DB;
    const bf16* GG = (const bf16*)(F.ws + WS_GG); const float* CB = (const float*)(F.ws + WS_CB); bf16* Y = (bf16*)(F.ws + WS_YB) + (size_t)T * DB;
    if (F.wave != 0) return;
    LAS float* blk = (LAS float*)F.lds;
    const int b = chain >> 3, hd = chain & 7, lane = F.lane, ch = hd * 64 + lane;
    const float lnw = A.in[19][ch], lnb = A.in[20][ch];
    float s[64];
#pragma unroll
    for (int j = 0; j < 64; ++j) s[j] = 0.f;
    for (int t0 = b * SEQ; t0 < (b + 1) * SEQ; t0 += 16) {
#pragma unroll
        for (int tk = 0; tk < 16; ++tk) { const size_t o = (size_t)(t0 + tk) * DB + ch;
            blk[(tk * 5 + 0) * 64 + lane] = NW[o]; blk[(tk * 5 + 1) * 64 + lane] = NKK[o]; blk[(tk * 5 + 2) * 64 + lane] = NBB[o]; blk[(tk * 5 + 3) * 64 + lane] = NKM[o]; blk[(tk * 5 + 4) * 64 + lane] = NR[o]; }
        LDS_WAIT(); asm volatile("" ::: "memory");
        for (int tk = 0; tk < 16; ++tk) { const int t = t0 + tk; const size_t o = (size_t)t * DB + ch;
            const float v = NVV[o];
            const LAS f32x4* wv = (const LAS f32x4*)(blk + (tk * 5 + 0) * 64); const LAS f32x4* kv = (const LAS f32x4*)(blk + (tk * 5 + 1) * 64); const LAS f32x4* bv = (const LAS f32x4*)(blk + (tk * 5 + 2) * 64);
            const LAS f32x4* mv = (const LAS f32x4*)(blk + (tk * 5 + 3) * 64); const LAS f32x4* rv = (const LAS f32x4*)(blk + (tk * 5 + 4) * 64);
            float sa = 0.f;
#pragma unroll
            for (int j = 0; j < 16; ++j) { const f32x4 k4 = kv[j]; sa += s[4 * j] * k4[0] + s[4 * j + 1] * k4[1] + s[4 * j + 2] * k4[2] + s[4 * j + 3] * k4[3]; }
            sa = -sa; float y = 0.f;
#pragma unroll
            for (int j = 0; j < 16; ++j) { const f32x4 w4 = wv[j], b4 = bv[j], m4 = mv[j], r4 = rv[j];
#pragma unroll
                for (int e = 0; e < 4; ++e) { const float ns = s[4 * j + e] * w4[e] + sa * b4[e] + v * m4[e]; s[4 * j + e] = ns; y += ns * r4[e]; } }
            const float mu = wave_sum(y) * (1.f / 64.f); const float dlt = y - mu; const float var = wave_sum(dlt * dlt) * (1.f / 64.f);
            const float yn = dlt * (1.0f / sqrtf(var + GN_EPS)) * lnw + lnb;
            const float outv = (yn + CB[(size_t)t * 8 + hd] * v) * bf2f(GG[o]);
            Y[o] = (bf16)f2bf(outv); }
        LDS_WAIT(); asm volatile("" ::: "memory");
    }
}

typedef float f32x2_t __attribute__((ext_vector_type(2))); typedef __bf16 bf16x2_t __attribute__((ext_vector_type(2)));
__device__ __forceinline__ unsigned cvtpk(float lo, float hi) { f32x2_t v = {lo, hi}; bf16x2_t b = __builtin_convertvector(v, bf16x2_t); return __builtin_bit_cast(unsigned, b); }
__device__ __forceinline__ f32x16 mfma32(const u32x4 a, const u32x4 b, const f32x16 c) { return __builtin_amdgcn_mfma_f32_32x32x16_bf16(__builtin_bit_cast(bf16x8, a), __builtin_bit_cast(bf16x8, b), c, 0, 0, 0); }
__device__ __forceinline__ void swap32(unsigned& a, unsigned& b) { auto r = __builtin_amdgcn_permlane32_swap(a, b, false, false); a = r[0]; b = r[1]; }
__device__ __forceinline__ void swap4(u32x4& a, u32x4& b) { unsigned a0 = a.x, a1 = a.y, a2 = a.z, a3 = a.w, b0 = b.x, b1 = b.y, b2 = b.z, b3 = b.w; swap32(a0, b0); swap32(a1, b1); swap32(a2, b2); swap32(a3, b3); a = (u32x4){a0, a1, a2, a3}; b = (u32x4){b0, b1, b2, b3}; }
#define F16Z ((f32x16){0.f, 0.f, 0.f, 0.f, 0.f, 0.f, 0.f, 0.f, 0.f, 0.f, 0.f, 0.f, 0.f, 0.f, 0.f, 0.f})
#define PACKC(c, sp) ((u32x4){cvtpk((c)[8 * (sp) + 0], (c)[8 * (sp) + 1]), cvtpk((c)[8 * (sp) + 2], (c)[8 * (sp) + 3]), cvtpk((c)[8 * (sp) + 4], (c)[8 * (sp) + 5]), cvtpk((c)[8 * (sp) + 6], (c)[8 * (sp) + 7])})
#define CROW0(reg) (((reg) & 3) + 8 * ((reg) >> 2))
__device__ __forceinline__ void load_rowfrags(const bf16* Xrm, int lane, u32x4 (&Fr)[2][4]) {
    const bf16* row = Xrm + lane * 256;
#pragma unroll
    for (int g = 0; g < 4; ++g) { const u32x2 a0 = *(const GAS u32x2*)(row + 16 * g), b0 = *(const GAS u32x2*)(row + 16 * g + 4), a1 = *(const GAS u32x2*)(row + 16 * g + 8), b1 = *(const GAS u32x2*)(row + 16 * g + 12);
        u32x4 P0 = {a0.x, a0.y, a1.x, a1.y}, P1 = {b0.x, b0.y, b1.x, b1.y};
        swap4(P0, P1);
        Fr[0][g] = P0; Fr[1][g] = P1; }
}
#define BLOB_ST(base, cidx, f, val) (*(GAS u32x4*)((base) + ((size_t)(cidx) * 8 + (f)) * 1024 + lane * 16) = (val))
#define BLOB_LD(base, cidx, f) (*(const GAS u32x4*)((base) + ((size_t)(cidx) * 8 + (f)) * 1024 + lane * 16))

__device__ __forceinline__ void rwkv_chunk_job(Frame& F, const Args& A, int job) {
    const bf16* P = (const bf16*)(F.ws + WS_P);
    int lane_ = F.lane; asm volatile("" : "+v"(lane_));
    const int lane = lane_, hd = F.wave, tid = hd * 64 + lane, r = lane & 31, h = lane >> 5, t0 = job * 64, c = hd * 64 + lane;
    const bool bstart = (t0 & (SEQ - 1)) == 0;
    LAS unsigned char* actb = F.lds;
    { const int t = tid >> 3, n0 = (tid & 7) * 32; const bf16* pa = P + (size_t)(t0 + t) * NINX + C_LA + n0; const bool hasprev = !(bstart && t == 0);
      const bf16* pb = P + (size_t)(t0 + t - (hasprev ? 1 : 0)) * NINX + C_LB + n0;
#pragma unroll
      for (int q = 0; q < 4; ++q) { const u32x4 wa = *(const GAS u32x4*)(pa + 8 * q); u32x4 wb = *(const GAS u32x4*)(pb + 8 * q); if (!hasprev) wb = (u32x4){0u, 0u, 0u, 0u};
          float v[8]; v[0] = bflo(wa.x) + bflo(wb.x); v[1] = bfhi(wa.x) + bfhi(wb.x); v[2] = bflo(wa.y) + bflo(wb.y); v[3] = bfhi(wa.y) + bfhi(wb.y); v[4] = bflo(wa.z) + bflo(wb.z); v[5] = bfhi(wa.z) + bfhi(wb.z); v[6] = bflo(wa.w) + bflo(wb.w); v[7] = bfhi(wa.w) + bfhi(wb.w);
#pragma unroll
          for (int e = 0; e < 8; ++e) { if (n0 < 64) v[e] = tanhf(v[e]); else if (n0 >= 128) v[e] = sigmoidf_(v[e]); }
          *(LAS u32x4*)(actb + ((size_t)t * 264 + n0 + 8 * q) * 2) = (u32x4){cvtpk(v[0], v[1]), cvtpk(v[2], v[3]), cvtpk(v[4], v[5]), cvtpk(v[6], v[7])}; } }
    {
      unsigned acc_ = 0u;
#pragma unroll
      for (int q = 0; q < 24; ++q) { const int ch = tid + 512 * q; const int row = ch / 192, col = ch - row * 192; const u32x4 w = *(const GAS u32x4*)(P + (size_t)(t0 + row) * NINX + C_RP + col * 8); acc_ ^= w.x ^ w.y ^ w.z ^ w.w; }
      asm volatile("" :: "v"(acc_)); }
    __syncthreads();
    const bf16* W2T = (const bf16*)(F.ws + WS_W2T); const bf16* A2T = (const bf16*)(F.ws + WS_A2T); const bf16* G2T = (const bf16*)(F.ws + WS_G2T);
    bf16* GG = (bf16*)(F.ws + WS_GG); float* CB = (float*)(F.ws + WS_CB); float* GC = (float*)(F.ws + WS_GC);
    { f32x16 ag[2][2];
#pragma unroll
      for (int mt = 0; mt < 2; ++mt)
#pragma unroll
          for (int nt = 0; nt < 2; ++nt) ag[mt][nt] = F16Z;
#pragma unroll
      for (int ks = 0; ks < 8; ++ks) { u32x4 af[2];
#pragma unroll
          for (int mt = 0; mt < 2; ++mt) af[mt] = *(const LAS u32x4*)(actb + ((size_t)(32 * mt + r) * 264 + 128 + 16 * ks + 8 * h) * 2);
#pragma unroll
          for (int nt = 0; nt < 2; ++nt) { const u32x4 bfr = *(const GAS u32x4*)(G2T + (size_t)(hd * 64 + 32 * nt + r) * 128 + 16 * ks + 8 * h);
#pragma unroll
              for (int mt = 0; mt < 2; ++mt) ag[mt][nt] = mfma32(af[mt], bfr, ag[mt][nt]); } }
#pragma unroll
      for (int mt = 0; mt < 2; ++mt)
#pragma unroll
          for (int nt = 0; nt < 2; ++nt)
#pragma unroll
              for (int reg = 0; reg < 16; ++reg) GG[(size_t)(t0 + 32 * mt + CROW0(reg) + 4 * h) * DB + hd * 64 + 32 * nt + r] = (bf16)f2bf(ag[mt][nt][reg]); }
    float lw_[64], av_[64];
    { f32x16 aw[2][2], aa[2][2];
#pragma unroll
      for (int mt = 0; mt < 2; ++mt)
#pragma unroll
          for (int nt = 0; nt < 2; ++nt) { aw[mt][nt] = F16Z; aa[mt][nt] = F16Z; }
#pragma unroll
      for (int ks = 0; ks < 4; ++ks) { u32x4 afw[2], afa[2];
#pragma unroll
          for (int mt = 0; mt < 2; ++mt) { afw[mt] = *(const LAS u32x4*)(actb + ((size_t)(32 * mt + r) * 264 + 16 * ks + 8 * h) * 2); afa[mt] = *(const LAS u32x4*)(actb + ((size_t)(32 * mt + r) * 264 + 64 + 16 * ks + 8 * h) * 2); }
#pragma unroll
          for (int nt = 0; nt < 2; ++nt) { const u32x4 bw = *(const GAS u32x4*)(W2T + (size_t)(hd * 64 + 32 * nt + r) * 64 + 16 * ks + 8 * h), ba = *(const GAS u32x4*)(A2T + (size_t)(hd * 64 + 32 * nt + r) * 64 + 16 * ks + 8 * h);
#pragma unroll
              for (int mt = 0; mt < 2; ++mt) { aw[mt][nt] = mfma32(afw[mt], bw, aw[mt][nt]); aa[mt][nt] = mfma32(afa[mt], ba, aa[mt][nt]); } } }
      const float w0c = A.in[10][c], a0c = A.in[13][c];
#pragma unroll
      for (int mt = 0; mt < 2; ++mt)
#pragma unroll
          for (int reg = 0; reg < 16; ++reg) { const float fx = aw[mt][0][reg], fy = aw[mt][1][reg], fp = aa[mt][0][reg], fq = aa[mt][1][reg];
              unsigned x = __float_as_uint(fx), y = __float_as_uint(fy); swap32(x, y);
              unsigned p = __float_as_uint(fp), q = __float_as_uint(fq); swap32(p, q);
              const int tA = 32 * mt + CROW0(reg);
              { const float xw = -(w0c + __builtin_bit_cast(float, x)); const float sp = fmaxf(xw, 0.f) + log1pf(__expf(-fabsf(xw))); lw_[tA] = -__expf(-sp - 0.5f); }
              { const float xw = -(w0c + __builtin_bit_cast(float, y)); const float sp = fmaxf(xw, 0.f) + log1pf(__expf(-fabsf(xw))); lw_[tA + 4] = -__expf(-sp - 0.5f); }
              av_[tA] = sigmoidf_(a0c + __builtin_bit_cast(float, p)); av_[tA + 4] = sigmoidf_(a0c + __builtin_bit_cast(float, q)); } }
    bf16* sb = (bf16*)(F.ws + WS_S2) + ((size_t)job * 8 + hd) * 32768; bf16* sbr = sb + 16384;
    { const float mu_r = A.in[6][c], mu_k = A.in[6][512 + c], mu_v = A.in[6][1024 + c], kkc = A.in[16][c], kac = A.in[17][c], rkc = A.in[18][c];
      float rp_p = 0.f, kp_p = 0.f, vp_p = 0.f, cum = 0.f;
      if (!bstart) { const bf16* pp = P + (size_t)(t0 - 1) * NINX; rp_p = bf2f(pp[C_RP + c]); kp_p = bf2f(pp[C_KP + c]); vp_p = bf2f(pp[C_VP + c]); }
      unsigned pkA[4], pkB[4], pkK[4], pkV[4]; float hA = 0.f, hB = 0.f, hK = 0.f, hV = 0.f, cbv = 0.f;
      const bf16* pl = P + (size_t)t0 * NINX + C_KP + c;
      bf16* ps = sb + lane; bf16* pr = sbr + lane * 256; float* pcb = CB + (size_t)t0 * 8 + hd;
      unsigned short qr[4], qk[4], qv[4];
#pragma unroll
      for (int i = 0; i < 4; ++i) { qr[i] = pl[(size_t)i * NINX - 512]; qk[i] = pl[(size_t)i * NINX]; qv[i] = pl[(size_t)i * NINX + 512]; }
      pl += 4 * NINX;
#pragma unroll
      for (int t = 0; t < 64; ++t) {
          if ((t & 15) == 0) asm volatile("" : "+v"(pl), "+v"(ps));
          const float rp = bf2f(qr[t & 3]), kp = bf2f(qk[t & 3]), vp = bf2f(qv[t & 3]);
          if (t + 4 < 64) { qr[t & 3] = pl[-512]; qk[t & 3] = pl[0]; qv[t & 3] = pl[512]; }
          const float r_ = rp + (rp_p - rp) * mu_r, k_ = kp + (kp_p - kp) * mu_k, v_ = vp + (vp_p - vp) * mu_v; rp_p = rp; kp_p = kp; vp_p = vp;
          const float a = av_[t];
          const float kkv = k_ * kkc; const float n2 = wave_sum_dpp(kkv * kkv); const float kk = kkv * __builtin_amdgcn_rsqf(fmaxf(n2, 1e-24f));
          const float km = k_ * (1.f + (a - 1.f) * kac);
          const float cb = wave_sum_dpp(r_ * km * rkc); cbv = (lane == t) ? cb : cbv;
          const float gp = __expf(cum); cum += lw_[t]; const float g = __expf(cum), ig = __expf(-cum);
          const float vA = -kk * gp, vB = kk * a * ig, vK = km * ig, vR = r_ * g;
          ps[0] = (bf16)f2bf(vA); ps[64] = (bf16)f2bf(vB); ps[128] = (bf16)f2bf(vK); ps[192] = (bf16)f2bf(vR);
          if ((t & 1) == 0) { hA = vA; hB = vB; hK = vK; hV = v_; }
          else { pkA[(t & 7) >> 1] = cvtpk(hA, vA); pkB[(t & 7) >> 1] = cvtpk(hB, vB); pkK[(t & 7) >> 1] = cvtpk(hK, vK); pkV[(t & 7) >> 1] = cvtpk(hV, v_); }
          if ((t & 7) == 7) { const int o = t - 7;
              *(GAS u32x4*)(pr + o) = (u32x4){pkA[0], pkA[1], pkA[2], pkA[3]}; *(GAS u32x4*)(pr + 64 + o) = (u32x4){pkB[0], pkB[1], pkB[2], pkB[3]};
              *(GAS u32x4*)(pr + 128 + o) = (u32x4){pkK[0], pkK[1], pkK[2], pkK[3]}; *(GAS u32x4*)(pr + 192 + o) = (u32x4){pkV[0], pkV[1], pkV[2], pkV[3]}; }
          pl += NINX; ps += 256; }
      pcb[lane * 8] = cbv;
      GC[((size_t)job * 8 + hd) * 64 + lane] = __expf(cum); }
    VM_WAIT();
    __syncthreads();
    const bf16 *At_tm = sb, *Bt_tm = sb + 64, *Kt_tm = sb + 128, *Rt_tm = sb + 192, *At_rm = sbr, *Bt_rm = sbr + 64, *Kt_rm = sbr + 128, *V_rm = sbr + 192;
#define FRAG_TM(X, tile, ks) (*(const GAS u32x4*)((X) + (32 * (tile) + r) * 256 + 16 * (ks) + 8 * h))
    LAS float* NT = (LAS float*)(F.lds + F.wave * 17408);
    const int cidx = job * 8 + hd;
    unsigned char* outb = (unsigned char*)F.out;
    const float gC0 = GC[(size_t)cidx * 64 + r], gC1 = GC[(size_t)cidx * 64 + 32 + r];
    u32x4 P2[2][2][2], P3[2][2][2];
    { u32x4 Af[2][4], Bf[2][4];
#pragma unroll
      for (int tl = 0; tl < 2; ++tl)
#pragma unroll
          for (int ks = 0; ks < 4; ++ks) { Af[tl][ks] = FRAG_TM(At_tm, tl, ks); Bf[tl][ks] = FRAG_TM(Bt_tm, tl, ks); }
#pragma unroll
      for (int mt = 0; mt < 2; ++mt)
#pragma unroll
          for (int nt = 0; nt < 2; ++nt) { if (mt == 1 && nt == 0) continue; f32x16 acc = F16Z;
#pragma unroll
              for (int ks = 0; ks < 4; ++ks) acc = mfma32(Bf[mt][ks], Af[nt][ks], acc);
#pragma unroll
              for (int g4 = 0; g4 < 4; ++g4) *(LAS f32x4*)(NT + (32 * nt + r) * 68 + 32 * mt + 8 * g4 + 4 * h) = (f32x4){acc[4 * g4], acc[4 * g4 + 1], acc[4 * g4 + 2], acc[4 * g4 + 3]}; }
      { u32x4 Kf[2][4];
#pragma unroll
        for (int tl = 0; tl < 2; ++tl)
#pragma unroll
            for (int ks = 0; ks < 4; ++ks) Kf[tl][ks] = FRAG_TM(Kt_tm, tl, ks);
#pragma unroll
        for (int mt = 0; mt < 2; ++mt)
#pragma unroll
            for (int nt = 0; nt < 2; ++nt) { f32x16 acc = F16Z;
                if (!(mt == 0 && nt == 1)) {
#pragma unroll
                    for (int ks = 0; ks < 4; ++ks) acc = mfma32(Af[mt][ks], Kf[nt][ks], acc);
                    if (mt == nt) {
#pragma unroll
                        for (int reg = 0; reg < 16; ++reg) acc[reg] = (r < CROW0(reg) + 4 * h) ? acc[reg] : 0.f; } }
                P2[mt][nt][0] = PACKC(acc, 0); P2[mt][nt][1] = PACKC(acc, 1); } }
      { u32x4 Rf[2][4];
#pragma unroll
        for (int tl = 0; tl < 2; ++tl)
#pragma unroll
            for (int ks = 0; ks < 4; ++ks) Rf[tl][ks] = FRAG_TM(Rt_tm, tl, ks);
#pragma unroll
        for (int mt = 0; mt < 2; ++mt)
#pragma unroll
            for (int nt = 0; nt < 2; ++nt) { f32x16 acc = F16Z;
                if (!(mt == 1 && nt == 0)) {
#pragma unroll
                    for (int ks = 0; ks < 4; ++ks) acc = mfma32(Bf[mt][ks], Rf[nt][ks], acc);
                    if (mt == nt) {
#pragma unroll
                        for (int reg = 0; reg < 16; ++reg) acc[reg] = (CROW0(reg) + 4 * h <= r) ? acc[reg] : 0.f; } }
                P3[mt][nt][0] = PACKC(acc, 0); P3[mt][nt][1] = PACKC(acc, 1); } } }
    LDS_WAIT(); asm volatile("" ::: "memory");
    u32x4 TA[2][4];
    { float Tr[64];
#pragma unroll
      for (int t = 0; t < 64; ++t) { float col = (lane == t) ? 1.f : 0.f;
#pragma unroll
          for (int q = 0; q < (t + 3) / 4; ++q) { const f32x4 nv = *(const LAS f32x4*)(NT + t * 68 + 4 * q);
#pragma unroll
              for (int e = 0; e < 4; ++e) if (4 * q + e < t) col += Tr[4 * q + e] * nv[e]; }
          Tr[t] = col; }
#pragma unroll
      for (int g = 0; g < 4; ++g) { u32x4 P0 = {cvtpk(Tr[16 * g], Tr[16 * g + 1]), cvtpk(Tr[16 * g + 2], Tr[16 * g + 3]), cvtpk(Tr[16 * g + 8], Tr[16 * g + 9]), cvtpk(Tr[16 * g + 10], Tr[16 * g + 11])};
          u32x4 P1 = {cvtpk(Tr[16 * g + 4], Tr[16 * g + 5]), cvtpk(Tr[16 * g + 6], Tr[16 * g + 7]), cvtpk(Tr[16 * g + 12], Tr[16 * g + 13]), cvtpk(Tr[16 * g + 14], Tr[16 * g + 15])};
          swap4(P0, P1); TA[0][g] = P0; TA[1][g] = P1; } }
    u32x4 P5a[2][2][2], P5b[2][2][2];
    { u32x4 BB[2][4]; load_rowfrags(Bt_rm, lane, BB);
#pragma unroll
      for (int mt = 0; mt < 2; ++mt)
#pragma unroll
          for (int nt = 0; nt < 2; ++nt) { f32x16 acc = F16Z;
#pragma unroll
              for (int g = 0; g < 4; ++g) { if ((g >> 1) == 1 && nt == 0) continue; acc = mfma32(TA[mt][g], P3[g >> 1][nt][g & 1], acc); }
              P5a[mt][nt][0] = PACKC(acc, 0); P5a[mt][nt][1] = PACKC(acc, 1);
              acc = F16Z;
#pragma unroll
              for (int g = 0; g < 4; ++g) acc = mfma32(TA[mt][g], BB[nt][g], acc);
              P5b[mt][nt][0] = PACKC(acc, 0); P5b[mt][nt][1] = PACKC(acc, 1); } }
    u32x4 Q2P[2][2][2], HP[2][2][2];
    { u32x4 Kf[2][4], Rf[2][4];
#pragma unroll
      for (int tl = 0; tl < 2; ++tl)
#pragma unroll
          for (int ks = 0; ks < 4; ++ks) { Kf[tl][ks] = FRAG_TM(Kt_tm, tl, ks); Rf[tl][ks] = FRAG_TM(Rt_tm, tl, ks); }
#pragma unroll
      for (int mt = 0; mt < 2; ++mt)
#pragma unroll
          for (int nt = 0; nt < 2; ++nt) { f32x16 acc = F16Z;
              if (!(mt == 1 && nt == 0)) {
#pragma unroll
                  for (int ks = 0; ks < 4; ++ks) acc = mfma32(Kf[mt][ks], Rf[nt][ks], acc);
                  if (mt == nt) {
#pragma unroll
                      for (int reg = 0; reg < 16; ++reg) acc[reg] = (CROW0(reg) + 4 * h <= r) ? acc[reg] : 0.f; } }
#pragma unroll
              for (int m2 = 0; m2 < 2; ++m2)
#pragma unroll
                  for (int sp = 0; sp < 2; ++sp) { if (m2 == 0 && mt == 1) continue; acc = mfma32(P2[m2][mt][sp], P5a[m2][nt][sp], acc); }
              Q2P[mt][nt][0] = PACKC(acc, 0); Q2P[mt][nt][1] = PACKC(acc, 1); } }
#pragma unroll
    for (int mt = 0; mt < 2; ++mt)
#pragma unroll
        for (int nt = 0; nt < 2; ++nt) { f32x16 acc;
#pragma unroll
            for (int g4 = 0; g4 < 4; ++g4) { const u32x2 kv = *(const GAS u32x2*)(Kt_rm + (32 * nt + r) * 256 + 32 * mt + 8 * g4 + 4 * h); acc[4 * g4] = bflo(kv.x); acc[4 * g4 + 1] = bfhi(kv.x); acc[4 * g4 + 2] = bflo(kv.y); acc[4 * g4 + 3] = bfhi(kv.y); }
#pragma unroll
            for (int m2 = 0; m2 < 2; ++m2)
#pragma unroll
                for (int sp = 0; sp < 2; ++sp) { if (m2 == 0 && mt == 1) continue; acc = mfma32(P2[m2][mt][sp], P5b[m2][nt][sp], acc); }
            const float gc = nt ? gC1 : gC0;
#pragma unroll
            for (int reg = 0; reg < 16; ++reg) acc[reg] *= gc;
            HP[mt][nt][0] = PACKC(acc, 0); HP[mt][nt][1] = PACKC(acc, 1); }
    { u32x4 VB[2][4]; load_rowfrags(V_rm, lane, VB);
      unsigned char* bd = F.ws + WS_BD + (size_t)cidx * 16384;
#pragma unroll
      for (int mt = 0; mt < 2; ++mt)
#pragma unroll
          for (int nt = 0; nt < 2; ++nt) { f32x16 acc = F16Z;
#pragma unroll
              for (int m2 = 0; m2 < 2; ++m2)
#pragma unroll
                  for (int sp = 0; sp < 2; ++sp) acc = mfma32(HP[m2][mt][sp], VB[nt][2 * m2 + sp], acc);
#pragma unroll
              for (int g4 = 0; g4 < 4; ++g4) *(GAS f32x4*)(bd + ((size_t)(((mt * 2 + nt) * 4 + g4) * 64 + lane)) * 16) = (f32x4){acc[4 * g4], acc[4 * g4 + 1], acc[4 * g4 + 2], acc[4 * g4 + 3]};
              acc = F16Z;
#pragma unroll
              for (int g = 0; g < 4; ++g) { if ((g >> 1) == 1 && nt == 0) continue; acc = mfma32(VB[mt][g], Q2P[g >> 1][nt][g & 1], acc); }
              BLOB_ST(outb + OUT_BYL, cidx, (mt * 2 + nt) * 2 + 0, PACKC(acc, 0)); BLOB_ST(outb + OUT_BYL, cidx, (mt * 2 + nt) * 2 + 1, PACKC(acc, 1)); } }
    { u32x4 AA[2][4]; load_rowfrags(At_rm, lane, AA);
#pragma unroll
      for (int mt = 0; mt < 2; ++mt)
#pragma unroll
          for (int nt = 0; nt < 2; ++nt) { f32x16 acc;
#pragma unroll
              for (int g4 = 0; g4 < 4; ++g4) { const u32x2 rv = *(const GAS u32x2*)(Rt_tm + (32 * nt + r) * 256 + 32 * mt + 8 * g4 + 4 * h); acc[4 * g4] = bflo(rv.x); acc[4 * g4 + 1] = bfhi(rv.x); acc[4 * g4 + 2] = bflo(rv.y); acc[4 * g4 + 3] = bfhi(rv.y); }
#pragma unroll
              for (int g = 0; g < 4; ++g) acc = mfma32(AA[mt][g], P5a[g >> 1][nt][g & 1], acc);
              BLOB_ST(outb + OUT_BQ1, cidx, (mt * 2 + nt) * 2 + 0, PACKC(acc, 0)); BLOB_ST(outb + OUT_BQ1, cidx, (mt * 2 + nt) * 2 + 1, PACKC(acc, 1));
              acc = F16Z;
#pragma unroll
              for (int g = 0; g < 4; ++g) acc = mfma32(AA[mt][g], P5b[g >> 1][nt][g & 1], acc);
              const float gc = nt ? gC1 : gC0;
#pragma unroll
              for (int reg = 0; reg < 16; ++reg) { float x = acc[reg]; if (mt == nt) x += (CROW0(reg) + 4 * h == r) ? 1.f : 0.f; acc[reg] = x * gc; }
              BLOB_ST(outb + OUT_BG, cidx, (mt * 2 + nt) * 2 + 0, PACKC(acc, 0)); BLOB_ST(outb + OUT_BG, cidx, (mt * 2 + nt) * 2 + 1, PACKC(acc, 1)); } }
#undef FRAG_TM
    __syncthreads();
}

constexpr int CH_SLOTS = 5, CH_SLOT_BYTES = 24576;
__device__ __forceinline__ void rwkv_chain_wg(Frame& F, int chain) {
    const int lane = F.lane, b = chain >> 3, hd = chain & 7, wave = F.wave;
    unsigned char* outb = (unsigned char*)F.out;
    volatile LAS unsigned* ready = F.MISC + 64;
    volatile LAS unsigned* done = F.MISC + 72;
    if (wave >= 2) {
        for (int ch = wave - 2; ch < 128; ch += 6) { const int slot = ch % CH_SLOTS; const unsigned need = (unsigned)(ch / CH_SLOTS); const int cidx = (b * 128 + ch) * 8 + hd;
            u32x4 g[8]; f32x4 d[16];
#pragma unroll
            for (int f = 0; f < 8; ++f) g[f] = BLOB_LD(outb + OUT_BG, cidx, f);
#pragma unroll
            for (int f = 0; f < 16; ++f) d[f] = *(const GAS f32x4*)(F.ws + WS_BD + (size_t)cidx * 16384 + (size_t)f * 1024 + lane * 16);
            while (done[slot] < need || done[8 + slot] < need) __builtin_amdgcn_s_sleep(2);
            LAS unsigned char* sl = F.lds + slot * CH_SLOT_BYTES + lane * 16;
#pragma unroll
            for (int f = 0; f < 8; ++f) *(LAS u32x4*)(sl + f * 1024) = g[f];
#pragma unroll
            for (int f = 0; f < 16; ++f) *(LAS f32x4*)(sl + 8192 + f * 1024) = d[f];
            LDS_WAIT(); asm volatile("" ::: "memory");
            if (lane == 0) ready[slot] = need + 1u;
        }
    } else {
        const int nt = wave;
        f32x16 st[2] = {F16Z, F16Z};
        for (int ch = 0; ch < 128; ++ch) { const int slot = ch % CH_SLOTS; const unsigned need = (unsigned)(ch / CH_SLOTS) + 1u; const int cidx = (b * 128 + ch) * 8 + hd;
            u32x4 SP[2][2];
#pragma unroll
            for (int m2 = 0; m2 < 2; ++m2) { SP[m2][0] = PACKC(st[m2], 0); SP[m2][1] = PACKC(st[m2], 1);
                BLOB_ST(outb + OUT_BS, cidx, (m2 * 2 + nt) * 2 + 0, SP[m2][0]); BLOB_ST(outb + OUT_BS, cidx, (m2 * 2 + nt) * 2 + 1, SP[m2][1]); }
            while (ready[slot] < need) __builtin_amdgcn_s_sleep(1);
            asm volatile("" ::: "memory");
            const LAS unsigned char* sl = F.lds + slot * CH_SLOT_BYTES + lane * 16;
            u32x4 g_[8]; f32x16 acc[2];
#pragma unroll
            for (int f = 0; f < 8; ++f) g_[f] = *(const LAS u32x4*)(sl + f * 1024);
#pragma unroll
            for (int mt = 0; mt < 2; ++mt)
#pragma unroll
                for (int g4 = 0; g4 < 4; ++g4) { const f32x4 dv = *(const LAS f32x4*)(sl + 8192 + ((mt * 2 + nt) * 4 + g4) * 1024); acc[mt][4 * g4] = dv[0]; acc[mt][4 * g4 + 1] = dv[1]; acc[mt][4 * g4 + 2] = dv[2]; acc[mt][4 * g4 + 3] = dv[3]; }
            LDS_WAIT(); asm volatile("" ::: "memory");
            if (lane == 0) done[nt * 8 + slot] = need;
#pragma unroll
            for (int mt = 0; mt < 2; ++mt)
#pragma unroll
                for (int m2 = 0; m2 < 2; ++m2)
#pragma unroll
                    for (int sp = 0; sp < 2; ++sp) acc[mt] = mfma32(g_[(m2 * 2 + mt) * 2 + sp], SP[m2][sp], acc[mt]);
            st[0] = acc[0]; st[1] = acc[1]; }
    }
}

__device__ __forceinline__ void rwkv_out(Frame& F, const Args& A, int cidx) {
    const bf16* P = (const bf16*)(F.ws + WS_P); const bf16* GG = (const bf16*)(F.ws + WS_GG); const float* CB = (const float*)(F.ws + WS_CB); bf16* Y = (bf16*)(F.ws + WS_YB) + (size_t)T * DB;
    int lane_ = F.lane; asm volatile("" : "+v"(lane_));
    const int lane = lane_, r = lane & 31, h = lane >> 5, job = cidx >> 3, hd = cidx & 7, t0 = job * 64;
    const bool bstart = (t0 & (SEQ - 1)) == 0;
    const unsigned char* outb = (const unsigned char*)F.out;
    u32x4 SP[8], Q1[8];
#pragma unroll
    for (int f = 0; f < 8; ++f) { SP[f] = BLOB_LD(outb + OUT_BS, cidx, f); Q1[f] = BLOB_LD(outb + OUT_BQ1, cidx, f); }
    f32x16 y[2][2];
#pragma unroll
    for (int mt = 0; mt < 2; ++mt)
#pragma unroll
        for (int nt = 0; nt < 2; ++nt) { f32x16 acc;
#pragma unroll
            for (int sp = 0; sp < 2; ++sp) { const u32x4 w = BLOB_LD(outb + OUT_BYL, cidx, (mt * 2 + nt) * 2 + sp);
                acc[8 * sp + 0] = bflo(w.x); acc[8 * sp + 1] = bfhi(w.x); acc[8 * sp + 2] = bflo(w.y); acc[8 * sp + 3] = bfhi(w.y); acc[8 * sp + 4] = bflo(w.z); acc[8 * sp + 5] = bfhi(w.z); acc[8 * sp + 6] = bflo(w.w); acc[8 * sp + 7] = bfhi(w.w); }
#pragma unroll
            for (int m2 = 0; m2 < 2; ++m2)
#pragma unroll
                for (int sp = 0; sp < 2; ++sp) acc = mfma32(SP[(m2 * 2 + mt) * 2 + sp], Q1[(m2 * 2 + nt) * 2 + sp], acc);
            y[mt][nt] = acc; }
#pragma unroll
    for (int nt = 0; nt < 2; ++nt) { const int t = t0 + 32 * nt + r;
        float s1 = 0.f;
#pragma unroll
        for (int mt = 0; mt < 2; ++mt)
#pragma unroll
            for (int reg = 0; reg < 16; ++reg) s1 += y[mt][nt][reg];
        s1 += __shfl_xor(s1, 32); const float mu = s1 * (1.f / 64.f); float s2 = 0.f;
#pragma unroll
        for (int mt = 0; mt < 2; ++mt)
#pragma unroll
            for (int reg = 0; reg < 16; ++reg) { const float d = y[mt][nt][reg] - mu; s2 += d * d; }
        s2 += __shfl_xor(s2, 32); const float rstd = 1.0f / sqrtf(s2 * (1.f / 64.f) + GN_EPS);
        const float cb = CB[(size_t)t * 8 + hd]; const bool hasprev = !(bstart && nt == 0 && r == 0);
        const bf16* pv = P + (size_t)t * NINX + C_VP + hd * 64; const bf16* pvp = P + (size_t)(t - (hasprev ? 1 : 0)) * NINX + C_VP + hd * 64;
#pragma unroll
        for (int mt = 0; mt < 2; ++mt)
#pragma unroll
            for (int g4 = 0; g4 < 4; ++g4) { const int i0 = 32 * mt + 8 * g4 + 4 * h;
                const f32x4 lw = *(const GAS f32x4*)(A.in[19] + hd * 64 + i0), lb = *(const GAS f32x4*)(A.in[20] + hd * 64 + i0), mv = *(const GAS f32x4*)(A.in[6] + 1024 + hd * 64 + i0);
                const u32x2 v0 = *(const GAS u32x2*)(pv + i0); u32x2 v1 = *(const GAS u32x2*)(pvp + i0); if (!hasprev) v1 = (u32x2){0u, 0u};
                const u32x2 gg = *(const GAS u32x2*)(GG + (size_t)t * DB + hd * 64 + i0);
                float vv[4], vp_[4], gv[4]; vv[0] = bflo(v0.x); vv[1] = bfhi(v0.x); vv[2] = bflo(v0.y); vv[3] = bfhi(v0.y); vp_[0] = bflo(v1.x); vp_[1] = bfhi(v1.x); vp_[2] = bflo(v1.y); vp_[3] = bfhi(v1.y);
                gv[0] = bflo(gg.x); gv[1] = bfhi(gg.x); gv[2] = bflo(gg.y); gv[3] = bfhi(gg.y);
                float o[4];
#pragma unroll
                for (int e = 0; e < 4; ++e) { const float v = vv[e] + (vp_[e] - vv[e]) * mv[e]; o[e] = ((y[mt][nt][4 * g4 + e] - mu) * rstd * lw[e] + lb[e] + cb * v) * gv[e]; }
                *(GAS u32x2*)(Y + (size_t)t * DB + hd * 64 + i0) = (u32x2){cvtpk(o[0], o[1]), cvtpk(o[2], o[3])}; } }
}

__device__ __forceinline__ void router_job(Frame& F, const Args& A, int job) {
    const float* X2 = F.out; bf16* H2 = (bf16*)(F.ws + WS_H); const bf16* RH = (const bf16*)(F.ws + WS_RTHI); const bf16* RL = (const bf16*)(F.ws + WS_RTLO);
    int* ROUTE = (int*)(F.ws + WS_ROUTE); float* COMB = (float*)(F.ws + WS_ROUTE + 512 * 1024); int* LIST = (int*)(F.ws + WS_LIST); unsigned* CNT = (unsigned*)(F.ctl + CW_CNT);
    LAS float* lg = (LAS float*)(F.lds + F.wave * 8192);
    const int lane = F.lane, row = lane & 15, q = lane >> 4, tb = job * 16;
    const float* xr = X2 + (size_t)(tb + row) * D + 8 * q;
    float ss = 0.f;
#pragma unroll 8
    for (int ks = 0; ks < 32; ++ks) { const f32x4 a = *(const GAS f32x4*)(xr + 32 * ks), b = *(const GAS f32x4*)(xr + 32 * ks + 4); ss += (a.x * a.x + a.y * a.y) + (a.z * a.z + a.w * a.w) + (b.x * b.x + b.y * b.y) + (b.z * b.z + b.w * b.w); }
    ss += __shfl_xor(ss, 16); ss += __shfl_xor(ss, 32);
    const float rinv = 1.0f / sqrtf(ss * (1.f / D) + NORM_EPS);
    f32x4 acc[5];
#pragma unroll
    for (int nt = 0; nt < 5; ++nt) acc[nt] = (f32x4){0.f, 0.f, 0.f, 0.f};
    const float* gf = A.in[26] + 8 * q;
#pragma unroll 4
    for (int ks = 0; ks < 32; ++ks) {
        const f32x4 a = *(const GAS f32x4*)(xr + 32 * ks), b = *(const GAS f32x4*)(xr + 32 * ks + 4); const f32x4 ga = *(const GAS f32x4*)(gf + 32 * ks), gb = *(const GAS f32x4*)(gf + 32 * ks + 4);
        float hv[8]; hv[0] = a.x * rinv * ga.x; hv[1] = a.y * rinv * ga.y; hv[2] = a.z * rinv * ga.z; hv[3] = a.w * rinv * ga.w; hv[4] = b.x * rinv * gb.x; hv[5] = b.y * rinv * gb.y; hv[6] = b.z * rinv * gb.z; hv[7] = b.w * rinv * gb.w;
        unsigned hi[8], lo[8];
#pragma unroll
        for (int e = 0; e < 8; ++e) { hi[e] = f2bf(hv[e]); lo[e] = f2bf(hv[e] - bf2f(hi[e])); }
        const u32x4 hw = {hi[0] | (hi[1] << 16), hi[2] | (hi[3] << 16), hi[4] | (hi[5] << 16), hi[6] | (hi[7] << 16)};
        const u32x4 lw = {lo[0] | (lo[1] << 16), lo[2] | (lo[3] << 16), lo[4] | (lo[5] << 16), lo[6] | (lo[7] << 16)};
        *(GAS u32x4*)(H2 + (size_t)(tb + row) * D + 32 * ks + 8 * q) = hw;
        const bf16x8 ah = __builtin_bit_cast(bf16x8, hw), al = __builtin_bit_cast(bf16x8, lw);
#pragma unroll
        for (int nt = 0; nt < 5; ++nt) { const size_t wo = (size_t)(16 * nt + row) * 1024 + 32 * ks + 8 * q;
            const bf16x8 bh = *(const GAS bf16x8*)(RH + wo), bl = *(const GAS bf16x8*)(RL + wo);
            acc[nt] = __builtin_amdgcn_mfma_f32_16x16x32_bf16(ah, bh, acc[nt], 0, 0, 0);
            acc[nt] = __builtin_amdgcn_mfma_f32_16x16x32_bf16(al, bh, acc[nt], 0, 0, 0);
            acc[nt] = __builtin_amdgcn_mfma_f32_16x16x32_bf16(ah, bl, acc[nt], 0, 0, 0); }
    }
#pragma unroll
    for (int nt = 0; nt < 5; ++nt)
#pragma unroll
        for (int r = 0; r < 4; ++r) lg[(4 * q + r) * 80 + 16 * nt + row] = acc[nt][r];
    LDS_WAIT(); asm volatile("" ::: "memory");
    if (lane < 16) { const int t = tb + lane; const LAS float* l = lg + lane * 80;
        float gl[8]; int gs = 0; float gm = -3.0e38f;
#pragma unroll
        for (int i = 0; i < 8; ++i) { gl[i] = l[i] + A.in[28][i]; if (gl[i] > gm) { gm = gl[i]; gs = i; } }
        float gsum = 0.f;
#pragma unroll
        for (int i = 0; i < 8; ++i) gsum += __expf(gl[i] - gm);
        const float gw = 1.0f / gsum;
        float e0v = -3.0e38f, e1v = -3.0e38f; int i0 = 0, i1 = 0;
#pragma unroll
        for (int i = 0; i < 8; ++i) { const float v = l[8 + gs * 8 + i] + A.in[30][gs * 8 + i];
            if (v > e0v) { e1v = e0v; i1 = i0; e0v = v; i0 = i; } else if (v > e1v) { e1v = v; i1 = i; } }
        const float x = __expf(e1v - e0v); const float c0 = gw / (1.f + x), c1 = gw * x / (1.f + x);
        const int e0 = gs * 8 + i0, e1 = gs * 8 + i1;
        const int p0 = (int)__hip_atomic_fetch_add(CNT + 64 * e0, 1u, RLX_AGENT), p1 = (int)__hip_atomic_fetch_add(CNT + 64 * e1, 1u, RLX_AGENT);
        LIST[(size_t)e0 * T + p0] = t; LIST[(size_t)e1 * T + p1] = t;
        ROUTE[4 * t + 0] = e0; ROUTE[4 * t + 1] = p0; ROUTE[4 * t + 2] = e1; ROUTE[4 * t + 3] = p1; COMB[2 * t] = c0; COMB[2 * t + 1] = c1; }
    LDS_WAIT(); asm volatile("" ::: "memory");
}

__device__ __forceinline__ void moe_build_table(Frame& F) {
    volatile LAS int* tab = (volatile LAS int*)(F.lds + MOE_OFF);
    if (F.tid < NEXP) tab[F.tid] = (int)__hip_atomic_load((unsigned*)(F.ctl + CW_CNT) + 64 * F.tid, RLX_AGENT);
    __syncthreads();
    if (F.tid == 0) { int run = 0;
        for (int e = 0; e < NEXP; ++e) { tab[64 + e] = run; run += (tab[e] + 255) >> 8; }
        tab[128] = run; tab[129] = run;
        const int U = run * 4; int e = 0;
        for (int i = 0; i < pg8::MOE_MAXU; ++i) { const int L = i * F.G + (int)blockIdx.x;
            if (L < U) { const int q = U / 8, r = U % 8, xcd = L % 8, off = L / 8; const int id = (xcd < r ? xcd * (q + 1) : r * (q + 1) + (xcd - r) * q) + off;
                const int gt = id >> 2, pn = id & 3; e = 0; while (e < NEXP - 1 && tab[64 + e + 1] <= gt) ++e;
                tab[136 + 4 * i] = e; tab[136 + 4 * i + 1] = gt; tab[136 + 4 * i + 2] = pn; tab[136 + 4 * i + 3] = gt - tab[64 + e]; }
            else tab[136 + 4 * i] = -1; } }
    __syncthreads();
}
__device__ __forceinline__ void final_rows(Frame& F, const Args& A, int gw, int NGW) {
    volatile LAS int* tab = (volatile LAS int*)(F.lds + MOE_OFF);
    const int* ROUTE = (const int*)(F.ws + WS_ROUTE); const float* COMB = (const float*)(F.ws + WS_ROUTE + 512 * 1024); const bf16* YM = (const bf16*)(F.ws + WS_YMOE);
    for (int t = gw; t < T; t += NGW) {
        const int e0 = ROUTE[4 * t], p0 = ROUTE[4 * t + 1], e1 = ROUTE[4 * t + 2], p1 = ROUTE[4 * t + 3]; const float c0 = COMB[2 * t], c1 = COMB[2 * t + 1];
        const size_t r0 = (size_t)tab[64 + e0] * 256 + p0, r1 = (size_t)tab[64 + e1] * 256 + p1;
        GAS f32x4* xr = (GAS f32x4*)(F.out + (size_t)t * D) + F.lane; const GAS u32x2* y0 = (const GAS u32x2*)(YM + r0 * D) + F.lane; const GAS u32x2* y1 = (const GAS u32x2*)(YM + r1 * D) + F.lane;
        f32x4 v[4]; float s = 0.f;
#pragma unroll
        for (int j = 0; j < 4; ++j) { v[j] = xr[64 * j]; const u32x2 a = y0[64 * j], b = y1[64 * j];
            v[j].x += c0 * bflo(a.x) + c1 * bflo(b.x); v[j].y += c0 * bfhi(a.x) + c1 * bfhi(b.x); v[j].z += c0 * bflo(a.y) + c1 * bflo(b.y); v[j].w += c0 * bfhi(a.y) + c1 * bfhi(b.y);
            s += (v[j].x * v[j].x + v[j].y * v[j].y) + (v[j].z * v[j].z + v[j].w * v[j].w); }
        const float rinv = 1.0f / sqrtf(wave_sum(s) * (1.f / D) + NORM_EPS);
        const GAS f32x4* gr = (const GAS f32x4*)A.in[34] + F.lane;
#pragma unroll
        for (int j = 0; j < 4; ++j) xr[64 * j] = v[j] * rinv * gr[64 * j];
    }
}

constexpr int N_PHASES = 11;
__global__ void __launch_bounds__(NWAVES * 64, 2) mk_fwd(Args args) {
    extern __shared__ __attribute__((aligned(16))) unsigned char lds[];
    Frame F;
    F.lds = (LAS unsigned char*)lds;
    F.MISC = (volatile LAS unsigned*)(F.lds + MISC_OFF);
    F.tid = threadIdx.x; F.lane = F.tid & 63; F.wave = __builtin_amdgcn_readfirstlane(F.tid >> 6);
    F.G = gridDim.x; { const int bx = blockIdx.x; F.vcu = (F.G % 8 == 0) ? (bx % 8) * (F.G / 8) + bx / 8 : bx; }
    unsigned char* ws = args.ws; F.ws = ws; F.out = args.out;
    F.ctl = (gu32*)(ws + WS_CTL);
    for (int u = F.tid; u < (LDS_BYTES - LDSCTL_OFF) / 4; u += NWAVES * 64) ((LAS unsigned*)(F.lds + LDSCTL_OFF))[u] = 0u;
    __syncthreads();
#if MK_MULTI
#define GRID_BAR() do { } while (0)
#else
    XcdBarrier bar = xcd_barrier_post((unsigned*)(F.ctl + CW_BAR), F.MISC + 8);
#define GRID_BAR() xcd_barrier(bar)
#endif
    const int lo = args.ph_lo, hi = args.ph_hi;
#define IN(k) (lo <= (k) && (k) < hi)
#define BOTH(k) (IN(k) && IN((k) + 1))
    const int gw = F.vcu * NWAVES + F.wave, NGW = F.G * NWAVES;
    const char* wsc = (const char*)ws;

    if (IN(0)) { p0_prologue(F, args); if (BOTH(0)) GRID_BAR(); }
    if (IN(1)) {
        pg8::SchedP1 S{F.G, (int)blockIdx.x, wsc + WS_H, wsc + WS_MEMN, wsc + WS_WIN, wsc + WS_WKV, false};
        pg8::EpiP E{(bf16*)(ws + WS_P), (bf16*)(ws + WS_KB), (bf16*)(ws + WS_VT)};
        pg8::gemm_phase<pg8::EpiP, pg8::SchedP1, false>(F.lds, S, E);
        if (BOTH(1)) GRID_BAR();
    }
    if (IN(2)) {
        for (int j = blockIdx.x; j < T / 64; j += F.G) { rwkv_chunk_job(F, args, j); conv_job(F, args, j); }
        if (BOTH(2)) GRID_BAR();
    }
    if (IN(3)) {
        if (F.G >= 64) {
            if (blockIdx.x < NB * NHEAD) rwkv_chain_wg(F, (int)blockIdx.x);
            else {
                if (blockIdx.x < NB * NHEAD + 8) {
                    pg8::SchedP1 S{F.G, (int)blockIdx.x - NB * NHEAD, wsc + WS_H, wsc + WS_MEMN, wsc + WS_WIN, wsc + WS_WKV, true};
                    pg8::EpiP E{(bf16*)(ws + WS_P), (bf16*)(ws + WS_KB), (bf16*)(ws + WS_VT)};
                    pg8::gemm_phase<pg8::EpiP, pg8::SchedP1, false>(F.lds, S, E);
                }
                convert_experts(F, args, ((int)blockIdx.x - NB * NHEAD) * NWAVES + F.wave, (F.G - NB * NHEAD) * NWAVES);
            }
        } else {
            { pg8::SchedP1 S{F.G, (int)blockIdx.x, wsc + WS_H, wsc + WS_MEMN, wsc + WS_WIN, wsc + WS_WKV, true};
              pg8::EpiP E{(bf16*)(ws + WS_P), (bf16*)(ws + WS_KB), (bf16*)(ws + WS_VT)};
              pg8::gemm_phase<pg8::EpiP, pg8::SchedP1, false>(F.lds, S, E); }
            if (blockIdx.x < NB * NHEAD && F.G >= NB * NHEAD) rwkv_chain_wg(F, (int)blockIdx.x);
            convert_experts(F, args, gw, NGW);
        }
        if (BOTH(3)) GRID_BAR();
    }
    if (IN(4)) { for (int ci = gw; ci < (T / 64) * NHEAD; ci += NGW) rwkv_out(F, args, ci); for (int u = blockIdx.x; u < 256; u += F.G) mem_attn_unit(F, u); if (BOTH(4)) GRID_BAR(); }
    if (IN(5)) {
        pg8::SchedMerge S{F.G, (int)blockIdx.x, wsc + WS_H, wsc + WS_YB, wsc + WS_WGATE, wsc + WS_WBR};
        pg8::EpiMerge E{args.in[24], (bf16*)(ws + WS_GS) + (size_t)blockIdx.x * 65536, (bf16*)(ws + WS_Z)};
        pg8::gemm_phase<pg8::EpiMerge, pg8::SchedMerge, false>(F.lds, S, E);
        if (BOTH(5)) GRID_BAR();
    }
    if (IN(6)) {
        pg8::SchedX2 S{F.G, (int)blockIdx.x, wsc + WS_Z, wsc + WS_WO};
        pg8::EpiX2 E{args.in[0], F.out};
        pg8::gemm_phase<pg8::EpiX2, pg8::SchedX2, false>(F.lds, S, E);
        if (BOTH(6)) GRID_BAR();
    }
    if (IN(7)) { if (F.wave < 4) for (int j = F.vcu * 4 + F.wave; j < T / 16; j += F.G * 4) router_job(F, args, j); if (BOTH(7)) GRID_BAR(); }
    if (IN(8)) {
        moe_build_table(F);
        pg8::SchedMoe S{(const volatile LAS int*)(F.lds + MOE_OFF), 1, wsc + WS_H, wsc + WS_HID, wsc + WS_E1, wsc + WS_E2, (const int*)(ws + WS_LIST)};
        pg8::EpiHid E{(bf16*)(ws + WS_HID)};
        pg8::gemm_phase<pg8::EpiHid, pg8::SchedMoe, true>(F.lds, S, E);
        if (BOTH(8)) GRID_BAR();
    }
    if (IN(9)) {
        moe_build_table(F);
        pg8::SchedMoe S{(const volatile LAS int*)(F.lds + MOE_OFF), 2, wsc + WS_H, wsc + WS_HID, wsc + WS_E1, wsc + WS_E2, (const int*)(ws + WS_LIST)};
        pg8::EpiY E{(bf16*)(ws + WS_YMOE)};
        pg8::gemm_phase<pg8::EpiY, pg8::SchedMoe, false>(F.lds, S, E);
        if (BOTH(9)) GRID_BAR();
    }
    if (IN(10)) { moe_build_table(F); final_rows(F, args, gw, NGW); }
#undef IN
#undef BOTH
}

extern "C" void kernel_launch(void* const* d_in, const int* in_sizes, int n_in, void* d_out, int out_size, void* d_ws, size_t ws_size, hipStream_t stream) {
    static int grid = 0;
    if (grid == 0) {
        if (n_in != 35 || in_sizes[0] != T * D || out_size != T * D || ws_size < WS_END) { fprintf(stderr, "kernel_launch: unexpected shapes / workspace (n_in %d, in0 %d, out %d, ws %zu)\n", n_in, n_in > 0 ? in_sizes[0] : -1, out_size, ws_size); grid = -1; return; }
        int dev = 0, cus = 0, per_cu = 0;
        if (hipGetDevice(&dev) != hipSuccess || hipDeviceGetAttribute(&cus, hipDeviceAttributeMultiprocessorCount, dev) != hipSuccess) { grid = -1; return; }
        if (hipFuncSetAttribute((const void*)mk_fwd, hipFuncAttributeMaxDynamicSharedMemorySize, LDS_BYTES) != hipSuccess) { fprintf(stderr, "kernel_launch: hipFuncSetAttribute failed\n"); grid = -1; return; }
        if (hipOccupancyMaxActiveBlocksPerMultiprocessor(&per_cu, (const void*)mk_fwd, NWAVES * 64, LDS_BYTES) != hipSuccess || per_cu < 1) fprintf(stderr, "kernel_launch: occupancy query reports %d\n", per_cu);
        (void)hipGetLastError();
        grid = cus;
    }
    if (grid < 0) return;
    if (hipMemsetAsync((char*)d_ws + WS_CTL, 0, CTL_ZERO_BYTES, stream) != hipSuccess) { fprintf(stderr, "kernel_launch: memset failed\n"); return; }
    Args a{};
    for (int i = 0; i < 35; ++i) a.in[i] = (const float*)d_in[i];
    a.out = (float*)d_out; a.ws = (unsigned char*)d_ws;
#if MK_MULTI
    for (int p = 0; p < N_PHASES; ++p) { a.ph_lo = p; a.ph_hi = p + 1; hipLaunchKernelGGL(mk_fwd, dim3(grid), dim3(NWAVES * 64), LDS_BYTES, stream, a); }
#else
    a.ph_lo = 0; a.ph_hi = N_PHASES; hipLaunchKernelGGL(mk_fwd, dim3(grid), dim3(NWAVES * 64), LDS_BYTES, stream, a);
#endif
    const hipError_t le = hipPeekAtLastError();
    if (le != hipSuccess) fprintf(stderr, "kernel_launch: launch failed: %s\n", hipGetErrorName(le));
}
```

```cpp
#include <hip/hip_runtime.h>
#include <cstdio>
#include <cstdint>

#ifndef MK_MULTI
#define MK_MULTI 0
#endif

#define GAS __attribute__((address_space(1)))
#define LAS __attribute__((address_space(3)))
typedef unsigned short bf16;
typedef short bf16x8 __attribute__((ext_vector_type(8)));
typedef float f32x4 __attribute__((ext_vector_type(4)));
typedef float f32x16 __attribute__((ext_vector_type(16)));
typedef unsigned u32x4 __attribute__((ext_vector_type(4)));
typedef unsigned u32x2 __attribute__((ext_vector_type(2)));

constexpr int NB = 2, SEQ = 8192, T = NB * SEQ, D = 1024, DB = 512, NHEAD = 8, HD = 64;
constexpr int NINX = 4096;
constexpr int MEML = 256, NEXP = 64, DEXP = 512;
constexpr int C_BG = 0, C_CG = 512, C_U = 1024, C_RP = 1536, C_KP = 2048, C_VP = 2560, C_Q = 3072, C_LA = 3584, C_LB = 3840;
constexpr float NORM_EPS = 1e-6f, GN_EPS = 64e-5f;
constexpr int MOE_ROWS = 49152;

constexpr size_t MiB = 1u << 20;
constexpr size_t WS_CTL = 0, CTL_ZERO_BYTES = 1 * MiB;
constexpr size_t WS_WIN = 1 * MiB, WS_WGATE = 9 * MiB, WS_WBR = 15 * MiB, WS_WO = 18 * MiB, WS_WKV = 20 * MiB, WS_MISCW = 22 * MiB;
constexpr size_t WS_RTHI = WS_MISCW, WS_RTLO = WS_MISCW + 256 * 1024;
constexpr size_t WS_W2T = WS_MISCW + 512 * 1024, WS_A2T = WS_MISCW + 576 * 1024, WS_G2T = WS_MISCW + 640 * 1024;
constexpr size_t WS_E1 = 24 * MiB, WS_E2 = 152 * MiB;
constexpr size_t WS_H = 216 * MiB;
constexpr size_t WS_MEMN = 248 * MiB, WS_KB = 249 * MiB, WS_VT = 249 * MiB + 512 * 1024;
constexpr size_t WS_P = 250 * MiB;
constexpr size_t WS_Z = WS_P;
constexpr size_t WS_HID = WS_P, WS_YMOE = 298 * MiB;
constexpr size_t WS_YB = 378 * MiB;
constexpr size_t WS_GS = 426 * MiB;
constexpr size_t WS_GG = 458 * MiB;
constexpr size_t WS_CB = 474 * MiB;
constexpr size_t WS_GC = 474 * MiB + 512 * 1024;
constexpr size_t WS_S2 = WS_E1;
constexpr size_t WS_BD = WS_GS;
constexpr size_t OUT_BG = 0, OUT_BQ1 = 16 * MiB, OUT_BYL = 32 * MiB, OUT_BS = 48 * MiB;
constexpr size_t WS_ROUTE = 475 * MiB;
constexpr size_t WS_LIST = 476 * MiB;
constexpr size_t WS_END = 480 * MiB;
constexpr size_t WS_NV = WS_E1;

constexpr int CW_BAR = 4096;
constexpr int CW_CNT = 16384;

constexpr int RING_BYTES = 131072;
constexpr int LDSCTL_OFF = 139264, MISC_OFF = LDSCTL_OFF + 320, MOE_OFF = LDSCTL_OFF + 1024;
constexpr int LDS_BYTES = 147456;

typedef GAS unsigned gu32;
#define RLX_AGENT __ATOMIC_RELAXED, __HIP_MEMORY_SCOPE_AGENT
#define LDS_WAIT() asm volatile("s_waitcnt lgkmcnt(0)" ::: "memory")
#define VM_WAIT() asm volatile("s_waitcnt vmcnt(0)" ::: "memory")
__device__ __forceinline__ unsigned f2bf(float f) { unsigned u = __builtin_bit_cast(unsigned, f); return (u + 0x7fffu + ((u >> 16) & 1u)) >> 16; }
__device__ __forceinline__ unsigned pk2(float lo, float hi) { return f2bf(lo) | (f2bf(hi) << 16); }
__device__ __forceinline__ float bf2f(unsigned b) { return __builtin_bit_cast(float, b << 16); }
__device__ __forceinline__ float bflo(unsigned w) { return __builtin_bit_cast(float, w << 16); }
__device__ __forceinline__ float bfhi(unsigned w) { return __builtin_bit_cast(float, w & 0xffff0000u); }
typedef float f32x2_t __attribute__((ext_vector_type(2))); typedef __bf16 bf16x2_t __attribute__((ext_vector_type(2)));
__device__ __forceinline__ unsigned cvt_pk_bf16(float lo, float hi) { f32x2_t v = {lo, hi}; bf16x2_t b = __builtin_convertvector(v, bf16x2_t); return __builtin_bit_cast(unsigned, b); }
__device__ __forceinline__ float wave_sum(float v) {
#pragma unroll
    for (int o = 1; o < 64; o <<= 1) v += __shfl_xor(v, o);
    return v;
}
__device__ __forceinline__ float dpp_add(float v, float src_from) { return v + src_from; }
#define DPPF(v, ctrl, rmask) __builtin_bit_cast(float, __builtin_amdgcn_update_dpp(0, __builtin_bit_cast(int, (v)), (ctrl), (rmask), 0xF, false))
__device__ __forceinline__ float wave_sum_dpp(float v) {
    v += DPPF(v, 0xB1, 0xF); v += DPPF(v, 0x4E, 0xF); v += DPPF(v, 0x141, 0xF); v += DPPF(v, 0x140, 0xF);
    v += DPPF(v, 0x142, 0xA); v += DPPF(v, 0x143, 0xC);
    return __builtin_bit_cast(float, __builtin_amdgcn_readlane(__builtin_bit_cast(int, v), 63));
}
__device__ __forceinline__ float sigmoidf_(float x) { return __builtin_amdgcn_rcpf(1.0f + __expf(-x)); }

namespace pg8 {
constexpr int BM = 256, BK = 64, HALF = 128, HTB = HALF * BK * 2, STAGE_BYTES = 8 * HTB;
__host__ __device__ __forceinline__ int lds_byte(int r, int c) { const int st = (r >> 4) * 2 + (c >> 5), rr = r & 15, cc = c & 31, ob = rr * 64 + cc * 2; return st * 1024 + (ob ^ (((ob >> 9) & 1) << 5)); }
__host__ __device__ __forceinline__ void stage_rc(int b, int& R, int& C) { const int st = b / 1024, sb = b % 1024, swz = sb ^ (((sb >> 9) & 1) << 5); R = (st >> 1) * 16 + swz / 64; C = (st & 1) * 32 + (swz % 64) / 2; }
__host__ __device__ __forceinline__ int perm32(int rho) { const int n = rho >> 4, i = rho & 15; return 8 * (i >> 2) + 4 * n + (i & 3); }

struct Unit { int pm, pn, sub, nt, lda, arow0, nrows; const char* abase; const char* pb; const int* rows; };
struct LaneOff { unsigned a[2][2]; unsigned b[2]; };

__device__ __forceinline__ void tile_map(int L, int nM, int nN, int& pm, int& pn) {
    const int nwg = nM * nN; int wgid = L; { const int q = nwg / 8, r = nwg % 8, xcd = wgid % 8, off = wgid / 8; wgid = (xcd < r ? xcd * (q + 1) : r * (q + 1) + (xcd - r) * q) + off; }
    const int nig = 8 * nN, gid = wgid / nig, fm = gid * 8, gsz = (nM - fm) < 8 ? (nM - fm) : 8;
    pm = fm + ((wgid % nig) % gsz); pn = (wgid % nig) / gsz;
}

template <class Epi, class Sched, bool GATHER>
__device__ __forceinline__ void gemm_phase(LAS unsigned char* lds, const Sched& S, const Epi& E) {
    const int tid = threadIdx.x, wid = __builtin_amdgcn_readfirstlane(tid >> 6), lane = tid & 63, wr = wid >> 2, wc = wid & 3, fr = lane & 15, fq = lane >> 4;
    int R_[2], C_[2], Rb_[2];
#pragma unroll
    for (int i = 0; i < 2; ++i) { int R, C; stage_rc(tid * 16 + i * 8192, R, C); R_[i] = R; C_[i] = C; Rb_[i] = Epi::PERM ? ((R & ~31) + perm32(R & 31)) : R; }
    const unsigned ldsw = (unsigned)wid * 1024u;
    const int aoff = lds_byte(wr * 64 + fr, fq * 8), boff = lds_byte(wc * 32 + fr, fq * 8);
#define PG8_MKOFF(u, o) do { _Pragma("unroll") for (int _h = 0; _h < 2; ++_h) _Pragma("unroll") for (int _i = 0; _i < 2; ++_i) { int _row; \
        if (GATHER) { const int _idx = _h * 128 + R_[_i]; _row = _idx < (u).nrows ? (u).rows[_idx] : 0; } else _row = (u).arow0 + _h * 128 + R_[_i]; \
        (o).a[_h][_i] = (unsigned)(_row * (u).lda + C_[_i]) * 2u; } \
        _Pragma("unroll") for (int _i = 0; _i < 2; ++_i) (o).b[_i] = (unsigned)(Rb_[_i] * ((u).nt * 64) + C_[_i]) * 2u; } while (0)
#define PG8_SA(b, h) (((b) * 2 + (h)) * HTB)
#define PG8_SB(b, h) ((4 + (b) * 2 + (h)) * HTB)
#define PG8_GLDS(src, bufoff, i) __builtin_amdgcn_global_load_lds((const unsigned*)(src), (LAS unsigned*)(lds + (bufoff) + ldsw + (i) * 8192), 16, 0, 0)
#define PG8_STAGE_A(bufoff, AB, O, h, kb) do { _Pragma("unroll") for (int _i = 0; _i < 2; ++_i) PG8_GLDS((AB) + (kb) + (O).a[h][_i], bufoff, _i); } while (0)
#define PG8_STAGE_B(bufoff, BB, O, h, hs, kb) do { _Pragma("unroll") for (int _i = 0; _i < 2; ++_i) PG8_GLDS((BB) + (size_t)(h) * (hs) + (kb) + (O).b[_i], bufoff, _i); } while (0)
#define PG8_LDA(dst, b, h) do { _Pragma("unroll") for (int m = 0; m < 4; ++m) _Pragma("unroll") for (int k = 0; k < 2; ++k) dst[m][k] = *(const LAS bf16x8*)(lds + PG8_SA(b, h) + aoff + m * 2048 + k * 1024); } while (0)
#define PG8_LDB(dst, b, h) do { _Pragma("unroll") for (int n = 0; n < 2; ++n) _Pragma("unroll") for (int k = 0; k < 2; ++k) dst[n][k] = *(const LAS bf16x8*)(lds + PG8_SB(b, h) + boff + n * 2048 + k * 1024); } while (0)
#define PG8_MMA(ai, bj, At, Bt) do { __builtin_amdgcn_s_setprio(1); _Pragma("unroll") for (int m = 0; m < 4; ++m) _Pragma("unroll") for (int n = 0; n < 2; ++n) _Pragma("unroll") for (int k = 0; k < 2; ++k) \
        acc[ai][bj][m][n] = __builtin_amdgcn_mfma_f32_16x16x32_bf16(Bt[n][k], At[m][k], acc[ai][bj][m][n], 0, 0, 0); __builtin_amdgcn_s_setprio(0); } while (0)
#define PG8_WAIT_V(n) asm volatile("s_waitcnt vmcnt(" #n ")" ::: "memory")
#define PG8_WAIT_L(n) asm volatile("s_waitcnt lgkmcnt(" #n ")" ::: "memory")
#define PG8_BAR __builtin_amdgcn_s_barrier()
#define PG8_SCHED __builtin_amdgcn_sched_barrier(0)
    Unit cur, nxt; int ui = 0;
    if (!S.next(0, cur)) return;
    LaneOff co, no;
    PG8_MKOFF(cur, co);
    no = co;
    f32x4 acc[2][2][4][2];
#pragma unroll
    for (int a = 0; a < 2; ++a)
#pragma unroll
        for (int b = 0; b < 2; ++b)
#pragma unroll
            for (int m = 0; m < 4; ++m)
#pragma unroll
                for (int n = 0; n < 2; ++n) acc[a][b][m][n] = (f32x4){0.f, 0.f, 0.f, 0.f};
    bf16x8 At[4][2], B0[2][2], B1[2][2];
    const char* cA = cur.abase; const char* cB = cur.pb; size_t chs = (size_t)cur.nt * 16384;
    PG8_STAGE_B(PG8_SB(0, 0), cB, co, 0, chs, 0); PG8_STAGE_B(PG8_SB(0, 1), cB, co, 1, chs, 0); PG8_STAGE_A(PG8_SA(0, 0), cA, co, 0, 0); PG8_STAGE_A(PG8_SA(0, 1), cA, co, 1, 0);
    if (wr == 1) PG8_BAR;
    PG8_WAIT_V(2); PG8_BAR;
    PG8_STAGE_B(PG8_SB(1, 0), cB, co, 0, chs, 128); PG8_STAGE_A(PG8_SA(1, 0), cA, co, 0, 128); PG8_STAGE_B(PG8_SB(1, 1), cB, co, 1, chs, 128);
    PG8_WAIT_V(6); PG8_BAR;
    for (;;) {
        const bool has_next = S.next(ui + 1, nxt);
        if (has_next) PG8_MKOFF(nxt, no);
        const char* nA = has_next ? nxt.abase : cA; const char* nB = has_next ? nxt.pb : cB; const size_t nhs = has_next ? (size_t)nxt.nt * 16384 : chs;
        const int nt = cur.nt;
        for (int t = 0; t < nt; t += 2) {
            const bool last = (t == nt - 2);
            const unsigned kb1 = (unsigned)(t + 1) * 128u;
            const char* A2 = last ? nA : cA; const char* B2 = last ? nB : cB; const size_t hs2 = last ? nhs : chs;
            const unsigned kb2 = last ? 0u : (unsigned)(t + 2) * 128u, kb3 = kb2 + 128u;
            LaneOff o2;
#pragma unroll
            for (int h = 0; h < 2; ++h)
#pragma unroll
                for (int i = 0; i < 2; ++i) o2.a[h][i] = (last && has_next) ? no.a[h][i] : co.a[h][i];
#pragma unroll
            for (int i = 0; i < 2; ++i) o2.b[i] = (last && has_next) ? no.b[i] : co.b[i];
            PG8_LDB(B0, 0, 0); PG8_LDB(B1, 0, 1); PG8_SCHED; PG8_LDA(At, 0, 0); PG8_STAGE_A(PG8_SA(1, 1), cA, co, 1, kb1);
            PG8_WAIT_V(8); PG8_WAIT_L(0); PG8_BAR; PG8_MMA(0, 0, At, B0); PG8_MMA(0, 1, At, B1); PG8_BAR; PG8_SCHED;
            PG8_LDA(At, 0, 1); PG8_STAGE_B(PG8_SB(0, 0), B2, o2, 0, hs2, kb2); PG8_STAGE_B(PG8_SB(0, 1), B2, o2, 1, hs2, kb2); PG8_STAGE_A(PG8_SA(0, 0), A2, o2, 0, kb2);
            PG8_WAIT_V(8); PG8_WAIT_L(0); PG8_BAR; PG8_MMA(1, 0, At, B0); PG8_MMA(1, 1, At, B1); PG8_BAR; PG8_SCHED;
            PG8_LDB(B0, 1, 0); PG8_LDB(B1, 1, 1); PG8_SCHED; PG8_LDA(At, 1, 0); PG8_STAGE_A(PG8_SA(0, 1), A2, o2, 1, kb2);
            PG8_WAIT_V(8); PG8_WAIT_L(0); PG8_BAR; PG8_MMA(0, 0, At, B0); PG8_MMA(0, 1, At, B1); PG8_BAR; PG8_SCHED;
            PG8_LDA(At, 1, 1); PG8_STAGE_B(PG8_SB(1, 0), B2, o2, 0, hs2, kb3); PG8_STAGE_B(PG8_SB(1, 1), B2, o2, 1, hs2, kb3); PG8_STAGE_A(PG8_SA(1, 0), A2, o2, 0, kb3);
            PG8_WAIT_V(8); PG8_WAIT_L(0); PG8_BAR; PG8_MMA(1, 0, At, B0); PG8_MMA(1, 1, At, B1); PG8_BAR; PG8_SCHED;
        }
        if (wr == 0) PG8_BAR;
        E(acc, cur, wr, wc, fr, fq, tid);
        if (!has_next) break;
#pragma unroll
        for (int a = 0; a < 2; ++a)
#pragma unroll
            for (int b = 0; b < 2; ++b)
#pragma unroll
                for (int m = 0; m < 4; ++m)
#pragma unroll
                    for (int n = 0; n < 2; ++n) acc[a][b][m][n] = (f32x4){0.f, 0.f, 0.f, 0.f};
        cur = nxt; cA = nA; cB = nB; chs = nhs; co = no; ++ui;
        if (wr == 1) PG8_BAR;
    }
    PG8_WAIT_V(0);
    PG8_BAR;
#undef PG8_MKOFF
#undef PG8_SA
#undef PG8_SB
#undef PG8_GLDS
#undef PG8_STAGE_A
#undef PG8_STAGE_B
#undef PG8_LDA
#undef PG8_LDB
#undef PG8_MMA
#undef PG8_WAIT_V
#undef PG8_WAIT_L
#undef PG8_BAR
#undef PG8_SCHED
}

typedef const f32x4 (&AccRef)[2][2][4][2];
__device__ __forceinline__ u32x4 pack8(const f32x4 v0, const f32x4 v1) { u32x4 w; w.x = cvt_pk_bf16(v0[0], v0[1]); w.y = cvt_pk_bf16(v0[2], v0[3]); w.z = cvt_pk_bf16(v1[0], v1[1]); w.w = cvt_pk_bf16(v1[2], v1[3]); return w; }

struct EpiP {
    static constexpr bool PERM = true;
    bf16* P; bf16* KB; bf16* VT;
    __device__ __forceinline__ void operator()(AccRef acc, const Unit& u, int wr, int wc, int fr, int fq, int tid) const {
        if (u.sub == 0) {
            const int row0 = u.pm * BM + wr * 64 + fr, col0 = u.pn * BM + wc * 32 + 8 * fq;
#pragma unroll
            for (int ai = 0; ai < 2; ++ai)
#pragma unroll
                for (int m = 0; m < 4; ++m) { bf16* rowp = P + (size_t)(row0 + ai * HALF + m * 16) * NINX + col0;
#pragma unroll
                    for (int bj = 0; bj < 2; ++bj) *(u32x4*)(rowp + bj * HALF) = pack8(acc[ai][bj][m][0], acc[ai][bj][m][1]); }
        } else {
#pragma unroll
            for (int ai = 0; ai < 2; ++ai)
#pragma unroll
                for (int m = 0; m < 4; ++m) { const int row = u.pm * BM + ai * HALF + wr * 64 + m * 16 + fr;
#pragma unroll
                    for (int bj = 0; bj < 2; ++bj)
#pragma unroll
                        for (int n = 0; n < 2; ++n)
#pragma unroll
                            for (int e = 0; e < 4; ++e) { const int col = u.pn * BM + bj * HALF + wc * 32 + 8 * fq + 4 * n + e; const bf16 v = (bf16)f2bf(acc[ai][bj][m][n][e]);
                                if (col < 512) KB[(size_t)row * 512 + col] = v;
                                else { const int c2 = col - 512, hd = c2 >> 7, d = c2 & 127, b = row >> 8, key = row & 255; VT[((size_t)(b * 4 + hd) * 128 + d) * 256 + key] = v; } } }
        }
    }
};
struct EpiMerge {
    static constexpr bool PERM = true;
    const float* bgate; bf16* Gs; bf16* Z;
    __device__ __forceinline__ void operator()(AccRef acc, const Unit& u, int wr, int wc, int fr, int fq, int tid) const {
        const int br = u.sub >> 1; const int col0 = u.pn * BM + wc * 32 + 8 * fq;
        int t2 = tid; asm volatile("" : "+v"(t2));
        bf16* gsp = Gs + (size_t)(t2 >> 3) * 1024 + (t2 & 7) * 8;
        if ((u.sub & 1) == 0) {
            f32x4 bv[2][2];
#pragma unroll
            for (int bj = 0; bj < 2; ++bj)
#pragma unroll
                for (int n = 0; n < 2; ++n) bv[bj][n] = *(const f32x4*)(bgate + br * 1024 + col0 + bj * HALF + 4 * n);
#pragma unroll
            for (int ai = 0; ai < 2; ++ai)
#pragma unroll
                for (int m = 0; m < 4; ++m)
#pragma unroll
                    for (int bj = 0; bj < 2; ++bj) { f32x4 v0 = acc[ai][bj][m][0] + bv[bj][0], v1 = acc[ai][bj][m][1] + bv[bj][1];
#pragma unroll
                        for (int e = 0; e < 4; ++e) { v0[e] = sigmoidf_(v0[e]); v1[e] = sigmoidf_(v1[e]); }
                        *(u32x4*)(gsp + ((ai * 4 + m) * 2 + bj) * 64) = pack8(v0, v1); }
        } else {
            const int row0 = u.pm * BM + wr * 64 + fr;
#pragma unroll
            for (int ai = 0; ai < 2; ++ai)
#pragma unroll
                for (int m = 0; m < 4; ++m) { bf16* zrow = Z + (size_t)(row0 + ai * HALF + m * 16) * 1024 + col0;
#pragma unroll
                    for (int bj = 0; bj < 2; ++bj) { const u32x4 g = __builtin_nontemporal_load((const GAS u32x4*)(gsp + ((ai * 4 + m) * 2 + bj) * 64));
                        f32x4 v0 = acc[ai][bj][m][0], v1 = acc[ai][bj][m][1];
                        v0[0] *= bflo(g.x); v0[1] *= bfhi(g.x); v0[2] *= bflo(g.y); v0[3] *= bfhi(g.y); v1[0] *= bflo(g.z); v1[1] *= bfhi(g.z); v1[2] *= bflo(g.w); v1[3] *= bfhi(g.w);
                        if (br > 0) { const u32x4 z = __builtin_nontemporal_load((const GAS u32x4*)(zrow + bj * HALF));
                            v0[0] += bflo(z.x); v0[1] += bfhi(z.x); v0[2] += bflo(z.y); v0[3] += bfhi(z.y); v1[0] += bflo(z.z); v1[1] += bfhi(z.z); v1[2] += bflo(z.w); v1[3] += bfhi(z.w); }
                        *(u32x4*)(zrow + bj * HALF) = pack8(v0, v1); } }
        }
    }
};
struct EpiX2 {
    static constexpr bool PERM = false;
    const float* x; float* out;
    __device__ __forceinline__ void operator()(AccRef acc, const Unit& u, int wr, int wc, int fr, int fq, int tid) const {
        const int row0 = u.pm * BM + wr * 64 + fr, col0 = u.pn * BM + wc * 32 + 4 * fq;
#pragma unroll
        for (int ai = 0; ai < 2; ++ai)
#pragma unroll
            for (int m = 0; m < 4; ++m) { const size_t off = (size_t)(row0 + ai * HALF + m * 16) * 1024 + col0;
#pragma unroll
                for (int bj = 0; bj < 2; ++bj)
#pragma unroll
                    for (int n = 0; n < 2; ++n) *(f32x4*)(out + off + bj * HALF + n * 16) = *(const f32x4*)(x + off + bj * HALF + n * 16) + acc[ai][bj][m][n]; }
    }
};
struct EpiHid {
    static constexpr bool PERM = true;
    bf16* HID;
    __device__ __forceinline__ void operator()(AccRef acc, const Unit& u, int wr, int wc, int fr, int fq, int tid) const {
        const int row0 = u.pm * BM + wr * 64 + fr, col0 = u.pn * HALF + wc * 32 + 8 * fq;
#pragma unroll
        for (int ai = 0; ai < 2; ++ai)
#pragma unroll
            for (int m = 0; m < 4; ++m) { f32x4 v0, v1;
#pragma unroll
                for (int e = 0; e < 4; ++e) { const float g0 = acc[ai][0][m][0][e], g1 = acc[ai][0][m][1][e]; v0[e] = g0 * sigmoidf_(g0) * acc[ai][1][m][0][e]; v1[e] = g1 * sigmoidf_(g1) * acc[ai][1][m][1][e]; }
                *(u32x4*)(HID + (size_t)(row0 + ai * HALF + m * 16) * DEXP + col0) = pack8(v0, v1); }
    }
};
struct EpiY {
    static constexpr bool PERM = true;
    bf16* Y;
    __device__ __forceinline__ void operator()(AccRef acc, const Unit& u, int wr, int wc, int fr, int fq, int tid) const {
        const int row0 = u.pm * BM + wr * 64 + fr, col0 = u.pn * BM + wc * 32 + 8 * fq;
#pragma unroll
        for (int ai = 0; ai < 2; ++ai)
#pragma unroll
            for (int m = 0; m < 4; ++m) { bf16* rowp = Y + (size_t)(row0 + ai * HALF + m * 16) * 1024 + col0;
#pragma unroll
                for (int bj = 0; bj < 2; ++bj) *(u32x4*)(rowp + bj * HALF) = pack8(acc[ai][bj][m][0], acc[ai][bj][m][1]); }
    }
};

struct SchedP1 {
    int G, c; const char *H, *MEMN, *WIN, *WKV; bool kvonly;
    __device__ __forceinline__ bool next(int i, Unit& u) const {
        int L = i * G + c;
        if (kvonly) { if (i > 0 || c >= 8) return false; const int pm = c >> 2, pn = c & 3; u.pm = pm; u.pn = pn; u.sub = 1; u.nt = 16; u.lda = 1024; u.arow0 = pm * 256; u.nrows = 0; u.abase = MEMN; u.pb = WKV + (size_t)pn * 256 * 2048; u.rows = nullptr; return true; }
        if (L < 1024) { int pm, pn; tile_map(L, 64, 16, pm, pn); u.pm = pm; u.pn = pn; u.sub = 0; u.nt = 16; u.lda = 1024; u.arow0 = pm * 256; u.nrows = 0; u.abase = H; u.pb = WIN + (size_t)pn * 256 * 2048; u.rows = nullptr; return true; }
        return false;
    }
};
struct SchedMerge {
    int G, c; const char *H, *YB, *WGT, *WBR;
    __device__ __forceinline__ bool next(int i, Unit& u) const {
        const int k = i / 6, sub = i - 6 * k; const int L = k * G + c; if (L >= 256) return false;
        int pm, pn; tile_map(L, 64, 4, pm, pn); const int br = sub >> 1;
        u.pm = pm; u.pn = pn; u.sub = sub; u.arow0 = pm * 256; u.nrows = 0; u.rows = nullptr;
        if ((sub & 1) == 0) { u.nt = 16; u.lda = 1024; u.abase = H; u.pb = WGT + ((size_t)(br * 1024 + pn * 256)) * 2048; }
        else { u.nt = 8; u.lda = 512; u.abase = YB + (size_t)br * T * 1024; u.pb = WBR + ((size_t)(br * 1024 + pn * 256)) * 1024; }
        return true;
    }
};
struct SchedX2 {
    int G, c; const char *Z, *WO;
    __device__ __forceinline__ bool next(int i, Unit& u) const {
        const int L = i * G + c; if (L >= 256) return false;
        int pm, pn; tile_map(L, 64, 4, pm, pn);
        u.pm = pm; u.pn = pn; u.sub = 0; u.nt = 16; u.lda = 1024; u.arow0 = pm * 256; u.nrows = 0; u.rows = nullptr; u.abase = Z; u.pb = WO + (size_t)pn * 256 * 2048; return true;
    }
};
constexpr int MOE_MAXU = 8;
struct SchedMoe {
    const volatile LAS int* tab; int phase;
    const char *H2, *HID, *W1, *W2; const int* LIST;
    __device__ __forceinline__ bool next(int i, Unit& u) const {
        if (i >= MOE_MAXU) return false;
        const int e = tab[136 + 4 * i]; if (e < 0) return false;
        const int gt = tab[136 + 4 * i + 1], pn = tab[136 + 4 * i + 2], rt = tab[136 + 4 * i + 3];
        u.pm = gt; u.pn = pn; u.sub = e;
        if (phase == 1) { u.nt = 16; u.lda = 1024; u.arow0 = 0; u.abase = H2; u.rows = LIST + (size_t)e * T + rt * 256; const int c = tab[e] - rt * 256; u.nrows = c < 256 ? c : 256; u.pb = W1 + ((size_t)e * 1024 + pn * 256) * 2048; }
        else { u.nt = 8; u.lda = 512; u.arow0 = gt * 256; u.abase = HID; u.rows = nullptr; u.nrows = 0; u.pb = W2 + ((size_t)e * 1024 + pn * 256) * 1024; }
        return true;
    }
};
}

#define XB_TMO      128
#define XB_XCNT(j)  (256  + 64 * (j))
#define XB_XSUB(j)  (1280 + 64 * (j))
#define XB_XGEN(j)  (2304 + 64 * (j))
#define XB_TOP      3328
#define XB_TOPGEN   3392
#define XCD_BAR_WORDS 3456
#define XB_SPIN_CAP (1u << 18)
__device__ __forceinline__ unsigned xb_ld(unsigned* p)              { return __hip_atomic_load(p, __ATOMIC_RELAXED, __HIP_MEMORY_SCOPE_AGENT); }
__device__ __forceinline__ unsigned xb_add(unsigned* p, unsigned v) { return __hip_atomic_fetch_add(p, v, __ATOMIC_RELAXED, __HIP_MEMORY_SCOPE_AGENT); }
__device__ __forceinline__ unsigned xb_xcc_id() { return (unsigned)__builtin_amdgcn_s_getreg((3 << 11) | 20) & 0xFu; }
#define XB_SPIN(cond, bar) do { unsigned _sp = 0; while (cond) { __builtin_amdgcn_s_sleep(1); \
    if ((++_sp & 255u) == 0u) { if (xb_ld(&(bar)[XB_TMO])) break; if (_sp > XB_SPIN_CAP) { atomicAdd(&(bar)[XB_TMO], 1u); break; } } } } while (0)
struct XcdBarrier { unsigned* bar; unsigned x; volatile LAS unsigned* st; };
__device__ __forceinline__ XcdBarrier xcd_barrier_post(unsigned* bar, volatile LAS unsigned* st) {
    XcdBarrier b; b.bar = bar; b.x = xb_xcc_id(); b.st = st;
    if (threadIdx.x == 0) (void)xb_add(&bar[XB_XCNT(b.x)], 1u);
    return b;
}
__device__ __forceinline__ void xcd_barrier_complete(unsigned* bar, unsigned x, unsigned& nloc, unsigned& nx) {
    const unsigned G = gridDim.x * gridDim.y * gridDim.z;
    unsigned sum, cnt, mine, sp = 0u;
    for (;;) {
        sum = 0u; cnt = 0u; mine = 0u;
#pragma unroll
        for (unsigned j = 0; j < 16; ++j) { const unsigned c = xb_ld(&bar[XB_XCNT(j)]); sum += c; cnt += (c > 0u) ? 1u : 0u; mine = (j == x) ? c : mine; }
        if (sum == G) break;
        __builtin_amdgcn_s_sleep(1);
        if ((++sp & 255u) == 0u) { if (xb_ld(&bar[XB_TMO])) break; if (sp > XB_SPIN_CAP) { atomicAdd(&bar[XB_TMO], 1u); break; } }
    }
    nloc = mine > 0u ? mine : 1u; nx = cnt > 0u ? cnt : 1u;
}
__device__ __forceinline__ void xcd_barrier(const XcdBarrier& b) {
    asm volatile("s_waitcnt vmcnt(0)" ::: "memory");
    __syncthreads();
    if (threadIdx.x == 0) {
        unsigned* bar = b.bar;
        __builtin_amdgcn_s_waitcnt(0);
        unsigned nloc = b.st[0], nx = b.st[1];
        if (nloc == 0u) { xcd_barrier_complete(bar, b.x, nloc, nx); b.st[0] = nloc; b.st[1] = nx; }
        const unsigned old = xb_add(&bar[XB_XSUB(b.x)], 1u);
        const unsigned gen = old / nloc;
        if (old + 1u == (gen + 1u) * nloc) {
            __builtin_amdgcn_fence(__ATOMIC_RELEASE, "agent");
            asm volatile("s_waitcnt vmcnt(0)" ::: "memory");
            const unsigned og = xb_add(&bar[XB_TOP], 1u);
            const unsigned tg = og / nx;
            if (og + 1u == (tg + 1u) * nx) xb_add(&bar[XB_TOPGEN], 1u);
            else XB_SPIN(xb_ld(&bar[XB_TOPGEN]) == tg, bar);
            __builtin_amdgcn_fence(__ATOMIC_ACQUIRE, "agent");
            xb_add(&bar[XB_XGEN(b.x)], 1u);
            asm volatile("s_waitcnt vmcnt(0)" ::: "memory");
        } else {
            XB_SPIN(xb_ld(&bar[XB_XGEN(b.x)]) == gen, bar);
            __builtin_amdgcn_fence(__ATOMIC_ACQUIRE, "agent");
            asm volatile("s_waitcnt vmcnt(0)" ::: "memory");
        }
    }
    __syncthreads();
}

constexpr int NWAVES = 8;
struct Args { const float* in[35]; float* out; unsigned char* ws; int ph_lo, ph_hi; };
struct Frame {
    LAS unsigned char* lds;
    volatile LAS unsigned* MISC;
    gu32* ctl;
    int tid, lane, wave, vcu, G;
    float* out; unsigned char* ws;
};

__device__ __forceinline__ void transpose_item(const float* W, int ldw, int K, int k0, int n0, bf16* WT, int drow0, const float* sc, int mode, LAS float* scr, int lane) {
    const int n4 = (lane & 7) * 4, kq = lane >> 3;
    f32x4 v[8];
#pragma unroll
    for (int i = 0; i < 8; ++i) v[i] = __builtin_nontemporal_load((const GAS f32x4*)(W + (size_t)(k0 + 8 * i + kq) * ldw + n0 + n4));
#pragma unroll
    for (int i = 0; i < 8; ++i) { const int kk = 8 * i + kq; f32x4 x = v[i];
        if (mode) { const float s = sc[k0 + kk]; x = x * ((mode == 1) ? s : (1.0f - s)); }
        LAS float* d = scr + kk * 33 + n4; d[0] = x.x; d[1] = x.y; d[2] = x.z; d[3] = x.w; }
    LDS_WAIT(); asm volatile("" ::: "memory");
    const int c = lane & 7;
#pragma unroll
    for (int j = 0; j < 4; ++j) { const int n = (lane >> 3) + 8 * j; const LAS float* s = scr + (8 * c) * 33 + n;
        u32x4 o; o.x = pk2(s[0 * 33], s[1 * 33]); o.y = pk2(s[2 * 33], s[3 * 33]); o.z = pk2(s[4 * 33], s[5 * 33]); o.w = pk2(s[6 * 33], s[7 * 33]);
        *(GAS u32x4*)(WT + (size_t)(drow0 + n) * K + k0 + 8 * c) = o; }
    LDS_WAIT(); asm volatile("" ::: "memory");
}
__device__ __forceinline__ void rms_row_to_bf16(const float* xrow, const float* g, bf16* orow, int lane) {
    const GAS f32x4* xr = (const GAS f32x4*)xrow + lane; const GAS f32x4* gr = (const GAS f32x4*)g + lane;
    f32x4 v[4]; float s = 0.f;
#pragma unroll
    for (int j = 0; j < 4; ++j) { v[j] = xr[64 * j]; s += (v[j].x * v[j].x + v[j].y * v[j].y) + (v[j].z * v[j].z + v[j].w * v[j].w); }
    const float rinv = 1.0f / sqrtf(wave_sum(s) * (1.f / D) + NORM_EPS);
    GAS unsigned long long* o8 = (GAS unsigned long long*)orow + lane;
#pragma unroll
    for (int j = 0; j < 4; ++j) { const f32x4 gv = gr[64 * j]; const f32x4 o = v[j] * rinv * gv; o8[64 * j] = (unsigned long long)pk2(o.x, o.y) | ((unsigned long long)pk2(o.z, o.w) << 32); }
}

__device__ __forceinline__ void p0_prologue(Frame& F, const Args& A) {
    LAS float* scr = (LAS float*)(F.lds + F.wave * 16384);
    const int gw = F.vcu * NWAVES + F.wave, NGW = F.G * NWAVES;
    bf16* WIN = (bf16*)(F.ws + WS_WIN); bf16* WGT = (bf16*)(F.ws + WS_WGATE); bf16* WBR = (bf16*)(F.ws + WS_WBR); bf16* WO = (bf16*)(F.ws + WS_WO); bf16* WKV = (bf16*)(F.ws + WS_WKV);
    constexpr int I_IN = 16 * 112, I_LO = 16 * 8, I_G = 16 * 96, I_BR = 8 * 32, I_O = 16 * 32, I_KV = 16 * 32;
    constexpr int NITEMS = I_IN + 2 * I_LO + I_G + 3 * I_BR + I_O + I_KV;
    for (int it = gw; it < NITEMS; it += NGW) {
        int r = it;
        if (r < I_IN) { const int kb = r / 112, nb = r % 112; transpose_item(A.in[4], 3584, 1024, 64 * kb, 32 * nb, WIN, 32 * nb, nullptr, 0, scr, F.lane); continue; } r -= I_IN;
        if (r < 2 * I_LO) { const int part = r / I_LO; r -= part * I_LO; const int kb = r / 8, nb = r % 8;
            const int n = 32 * nb; const float* W; int ldw, nn, mu;
            if (n < 64) { W = A.in[8]; ldw = 64; nn = n; mu = 0; } else if (n < 128) { W = A.in[11]; ldw = 64; nn = n - 64; mu = 1; } else { W = A.in[14]; ldw = 128; nn = n - 128; mu = 2; }
            transpose_item(W, ldw, 1024, 64 * kb, nn, WIN, (part == 0 ? C_LA : C_LB) + n, A.in[7] + mu * 1024, part == 0 ? 2 : 1, scr, F.lane); continue; } r -= 2 * I_LO;
        if (r < I_G) { const int kb = r / 96, nb = r % 96; transpose_item(A.in[23], 3072, 1024, 64 * kb, 32 * nb, WGT, 32 * nb, nullptr, 0, scr, F.lane); continue; } r -= I_G;
        if (r < 3 * I_BR) { const int br = r / I_BR; r -= br * I_BR; const int kb = r / 32, nb = r % 32; transpose_item(A.in[22] + (size_t)br * 512 * 1024, 1024, 512, 64 * kb, 32 * nb, WBR + (size_t)br * 1024 * 512, 32 * nb, nullptr, 0, scr, F.lane); continue; } r -= 3 * I_BR;
        if (r < I_O) { const int kb = r / 32, nb = r % 32; transpose_item(A.in[25], 1024, 1024, 64 * kb, 32 * nb, WO, 32 * nb, nullptr, 0, scr, F.lane); continue; } r -= I_O;
        { const int kb = r / 32, nb = r % 32; transpose_item(A.in[21], 1024, 1024, 64 * kb, 32 * nb, WKV, 32 * nb, nullptr, 0, scr, F.lane); }
    }
    for (int it = gw; it < 64; it += NGW) {
        if (it < 16) transpose_item(A.in[9], 512, 64, 0, 32 * it, (bf16*)(F.ws + WS_W2T), 32 * it, nullptr, 0, scr, F.lane);
        else if (it < 32) transpose_item(A.in[12], 512, 64, 0, 32 * (it - 16), (bf16*)(F.ws + WS_A2T), 32 * (it - 16), nullptr, 0, scr, F.lane);
        else { const int r2 = it - 32; transpose_item(A.in[15], 512, 128, 64 * (r2 >> 4), 32 * (r2 & 15), (bf16*)(F.ws + WS_G2T), 32 * (r2 & 15), nullptr, 0, scr, F.lane); } }
    { bf16* RH = (bf16*)(F.ws + WS_RTHI); bf16* RL = (bf16*)(F.ws + WS_RTLO);
      for (int idx = (F.vcu * NWAVES + F.wave) * 64 + F.lane; idx < 80 * 1024; idx += NGW * 64) { const int n = idx >> 10, k = idx & 1023;
          float w = 0.f; if (n < 8) w = A.in[27][k * 8 + n]; else if (n < 72) w = A.in[29][k * 64 + (n - 8)];
          const unsigned hi = f2bf(w); const float lo = w - bf2f(hi); RH[idx] = (bf16)hi; RL[idx] = (bf16)f2bf(lo); } }
    bf16* H = (bf16*)(F.ws + WS_H); bf16* MEMN = (bf16*)(F.ws + WS_MEMN);
    for (int m = gw; m < T; m += NGW) rms_row_to_bf16(A.in[0] + (size_t)m * D, A.in[2], H + (size_t)m * D, F.lane);
    for (int m = gw; m < NB * MEML; m += NGW) rms_row_to_bf16(A.in[1] + (size_t)m * D, A.in[3], MEMN + (size_t)m * D, F.lane);
}

__device__ __forceinline__ void convert_experts(Frame& F, const Args& A, int gw, int NGW) {
    LAS float* scr = (LAS float*)(F.lds + F.wave * 16384);
    bf16* E1 = (bf16*)(F.ws + WS_E1); bf16* E2 = (bf16*)(F.ws + WS_E2);
    constexpr int PER_E = 256;
    for (int it = gw; it < 3 * NEXP * PER_E; it += NGW) {
        const int mat = it / (NEXP * PER_E); int r = it - mat * (NEXP * PER_E); const int e = r / PER_E; r -= e * PER_E;
        if (mat < 2) { const int kb = r / 16, nb = r % 16, n = 32 * nb;
            transpose_item(A.in[31 + mat] + (size_t)e * 1024 * 512, 512, 1024, 64 * kb, n, E1 + (size_t)e * 1024 * 1024, (n >> 7) * 256 + mat * 128 + (n & 127), nullptr, 0, scr, F.lane); }
        else { const int kb = r / 32, nb = r % 32;
            transpose_item(A.in[33] + (size_t)e * 512 * 1024, 1024, 512, 64 * kb, 32 * nb, E2 + (size_t)e * 1024 * 512, 32 * nb, nullptr, 0, scr, F.lane); }
    }
}

__device__ __forceinline__ void mem_attn_unit(Frame& F, int unit) {
    const bf16* P = (const bf16*)(F.ws + WS_P); const bf16* KB = (const bf16*)(F.ws + WS_KB); const bf16* VT = (const bf16*)(F.ws + WS_VT); bf16* Y = (bf16*)(F.ws + WS_YB) + (size_t)2 * T * DB;
    const int b = unit >> 7, hd = (unit >> 5) & 3, qb = unit & 31;
    int tid_ = F.tid; asm volatile("" : "+v"(tid_));
    const int lane = tid_ & 63;
    LAS unsigned char* Kl = F.lds;
    LAS unsigned char* Vl = F.lds + 69632;
#pragma unroll
    for (int i = 0; i < 8; ++i) { const int ch = tid_ + 512 * i, row = ch >> 4, c16 = ch & 15;
        const u32x4 w = *(const GAS u32x4*)(KB + (size_t)(b * 256 + row) * 512 + hd * 128 + c16 * 8); *(LAS u32x4*)(Kl + row * 272 + c16 * 16) = w; }
#pragma unroll
    for (int i = 0; i < 8; ++i) { const int ch = tid_ + 512 * i, row = ch >> 5, c16 = ch & 31;
        const u32x4 w = *(const GAS u32x4*)(VT + ((size_t)(b * 4 + hd) * 128 + row) * 256 + c16 * 8);
        *(LAS u32x2*)(Vl + row * 520 + c16 * 16) = (u32x2){w.x, w.y}; *(LAS u32x2*)(Vl + row * 520 + c16 * 16 + 8) = (u32x2){w.z, w.w}; }
    const int t0 = b * SEQ + qb * 256 + F.wave * 32, rr = lane & 31, h = lane >> 5;
    bf16x8 qf[8];
    { const bf16* qrow = P + (size_t)(t0 + rr) * NINX + C_Q + hd * 128 + 8 * h;
#pragma unroll
      for (int ks = 0; ks < 8; ++ks) qf[ks] = *(const GAS bf16x8*)(qrow + 16 * ks); }
    __syncthreads();
    f32x16 s[8];
    const LAS unsigned char* kbase = Kl + rr * 272 + 16 * h;
#pragma unroll
    for (int kt = 0; kt < 8; ++kt) { f32x16 a = {0.f, 0.f, 0.f, 0.f, 0.f, 0.f, 0.f, 0.f, 0.f, 0.f, 0.f, 0.f, 0.f, 0.f, 0.f, 0.f};
#pragma unroll
        for (int ks = 0; ks < 8; ++ks) { const bf16x8 kf = *(const LAS bf16x8*)(kbase + kt * 32 * 272 + 32 * ks); a = __builtin_amdgcn_mfma_f32_32x32x16_bf16(kf, qf[ks], a, 0, 0, 0); }
        s[kt] = a; }
    float mx = -3.0e38f;
#pragma unroll
    for (int kt = 0; kt < 8; ++kt)
#pragma unroll
        for (int r = 0; r < 16; ++r) mx = fmaxf(mx, s[kt][r]);
    mx = fmaxf(mx, __shfl_xor(mx, 32));
    const float sc = 0.08838834764831845f * 1.4426950408889634f; float sum = 0.f;
#pragma unroll
    for (int kt = 0; kt < 8; ++kt)
#pragma unroll
        for (int r = 0; r < 16; ++r) { const float p = exp2f((s[kt][r] - mx) * sc); s[kt][r] = p; sum += p; }
    sum += __shfl_xor(sum, 32);
    const float inv = 1.0f / sum;
    f32x16 o[4];
#pragma unroll
    for (int dt = 0; dt < 4; ++dt) o[dt] = (f32x16){0.f, 0.f, 0.f, 0.f, 0.f, 0.f, 0.f, 0.f, 0.f, 0.f, 0.f, 0.f, 0.f, 0.f, 0.f, 0.f};
    const LAS unsigned char* vbase = Vl + rr * 520 + 8 * h;
#pragma unroll
    for (int kt = 0; kt < 8; ++kt)
#pragma unroll
        for (int sp = 0; sp < 2; ++sp) {
            u32x4 pw; pw.x = cvt_pk_bf16(s[kt][8 * sp + 0], s[kt][8 * sp + 1]); pw.y = cvt_pk_bf16(s[kt][8 * sp + 2], s[kt][8 * sp + 3]); pw.z = cvt_pk_bf16(s[kt][8 * sp + 4], s[kt][8 * sp + 5]); pw.w = cvt_pk_bf16(s[kt][8 * sp + 6], s[kt][8 * sp + 7]);
            const bf16x8 pb = __builtin_bit_cast(bf16x8, pw);
#pragma unroll
            for (int dt = 0; dt < 4; ++dt) { const LAS unsigned char* vp = vbase + dt * 32 * 520 + (32 * kt + 16 * sp) * 2;
                const u32x2 lo = *(const LAS u32x2*)(vp), hi = *(const LAS u32x2*)(vp + 16);
                const u32x4 vw = {lo.x, lo.y, hi.x, hi.y};
                o[dt] = __builtin_amdgcn_mfma_f32_32x32x16_bf16(__builtin_bit_cast(bf16x8, vw), pb, o[dt], 0, 0, 0); } }
    bf16* yrow = Y + (size_t)(t0 + rr) * DB + hd * 128 + 4 * h;
#pragma unroll
    for (int dt = 0; dt < 4; ++dt)
#pragma unroll
        for (int g = 0; g < 4; ++g) { u32x2 w; w.x = cvt_pk_bf16(o[dt][4 * g] * inv, o[dt][4 * g + 1] * inv); w.y = cvt_pk_bf16(o[dt][4 * g + 2] * inv, o[dt][4 * g + 3] * inv);
            *(GAS u32x2*)(yrow + 32 * dt + 8 * g) = w; }
    __syncthreads();
}

__device__ __forceinline__ void conv_job(Frame& F, const Args& A, int job) {
    const bf16* P = (const bf16*)(F.ws + WS_P); bf16* Y = (bf16*)(F.ws + WS_YB);
    int tid_ = F.tid; asm volatile("" : "+v"(tid_));
    const int c0 = (tid_ & 63) * 8, tr = tid_ >> 6, t0 = job * 64;
    float w[8][3];
#pragma unroll
    for (int e = 0; e < 8; ++e)
#pragma unroll
        for (int j = 0; j < 3; ++j) w[e][j] = A.in[5][(c0 + e) * 3 + j];
#pragma unroll 4
    for (int ps = 0; ps < 8; ++ps) { const int t = t0 + ps * 8 + tr, ts = t & (SEQ - 1); const bf16* p = P + (size_t)t * NINX + c0;
        const u32x4 zz = {0u, 0u, 0u, 0u};
        const u32x4 bg = *(const GAS u32x4*)(p + C_BG), g0 = *(const GAS u32x4*)(p + C_CG), u0 = *(const GAS u32x4*)(p + C_U);
        u32x4 g1 = zz, u1 = zz, g2 = zz, u2 = zz;
        if (ts >= 1) { g1 = *(const GAS u32x4*)(p - NINX + C_CG); u1 = *(const GAS u32x4*)(p - NINX + C_U); }
        if (ts >= 2) { g2 = *(const GAS u32x4*)(p - 2 * NINX + C_CG); u2 = *(const GAS u32x4*)(p - 2 * NINX + C_U); }
        float o[8];
#define CV(e, W) { const unsigned sh = ((e) & 1) ? 0u : 16u; const float b_ = __builtin_bit_cast(float, ((e) & 1) ? (bg.W & 0xffff0000u) : (bg.W << 16)); \
            const float c0_ = __builtin_bit_cast(float, ((e) & 1) ? (g0.W & 0xffff0000u) : (g0.W << 16)) * __builtin_bit_cast(float, ((e) & 1) ? (u0.W & 0xffff0000u) : (u0.W << 16)); \
            const float c1_ = __builtin_bit_cast(float, ((e) & 1) ? (g1.W & 0xffff0000u) : (g1.W << 16)) * __builtin_bit_cast(float, ((e) & 1) ? (u1.W & 0xffff0000u) : (u1.W << 16)); \
            const float c2_ = __builtin_bit_cast(float, ((e) & 1) ? (g2.W & 0xffff0000u) : (g2.W << 16)) * __builtin_bit_cast(float, ((e) & 1) ? (u2.W & 0xffff0000u) : (u2.W << 16)); \
            (void)sh; o[e] = b_ * (w[e][0] * c2_ + w[e][1] * c1_ + w[e][2] * c0_); }
        CV(0, x) CV(1, x) CV(2, y) CV(3, y) CV(4, z) CV(5, z) CV(6, w) CV(7, w)
#undef CV
        *(GAS u32x4*)(Y + (size_t)t * DB + c0) = (u32x4){cvt_pk_bf16(o[0], o[1]), cvt_pk_bf16(o[2], o[3]), cvt_pk_bf16(o[4], o[5]), cvt_pk_bf16(o[6], o[7])}; }
}

__device__ __forceinline__ void rwkv_prep_naive(Frame& F, const Args& A, int job) {
    const bf16* P = (const bf16*)(F.ws + WS_P);
    float* NW = (float*)(F.ws + WS_NV); float* NKK = NW + (size_t)T * DB; float* NBB = NKK + (size_t)T * DB; float* NKM = NBB + (size_t)T * DB; float* NVV = NKM + (size_t)T * DB; float* NR = NVV + (size_t)T * DB;
    bf16* GG = (bf16*)(F.ws + WS_GG); float* CB = (float*)(F.ws + WS_CB);
    LAS float* act = (LAS float*)F.lds;
    const int c = F.tid, hd = c >> 6;
    const float mu_r = A.in[6][c], mu_k = A.in[6][512 + c], mu_v = A.in[6][1024 + c];
    const float w0c = A.in[10][c], a0c = A.in[13][c], kkc = A.in[16][c], kac = A.in[17][c], rkc = A.in[18][c];
    for (int blk = 0; blk < 8; ++blk) {
        const int tb = job * 64 + blk * 8;
        if (c < 256) {
#pragma unroll
            for (int tk = 0; tk < 8; ++tk) { const int t = tb + tk; float v = bf2f(P[(size_t)t * NINX + C_LA + c]); if ((t & (SEQ - 1)) != 0) v += bf2f(P[(size_t)(t - 1) * NINX + C_LB + c]);
                if (c < 64) v = tanhf(v); else if (c >= 128) v = sigmoidf_(v);
                act[c * 8 + tk] = v; }
        }
        __syncthreads();
        float dw[8], da[8], dg[8];
#pragma unroll
        for (int k = 0; k < 8; ++k) { dw[k] = 0.f; da[k] = 0.f; dg[k] = 0.f; }
        for (int n = 0; n < 64; ++n) { const float wv = A.in[9][n * 512 + c], av = A.in[12][n * 512 + c];
            const f32x4 x0 = *(const LAS f32x4*)(act + n * 8), x1 = *(const LAS f32x4*)(act + n * 8 + 4), y0 = *(const LAS f32x4*)(act + (64 + n) * 8), y1 = *(const LAS f32x4*)(act + (64 + n) * 8 + 4);
#pragma unroll
            for (int k = 0; k < 4; ++k) { dw[k] += x0[k] * wv; dw[4 + k] += x1[k] * wv; da[k] += y0[k] * av; da[4 + k] += y1[k] * av; } }
        for (int n = 0; n < 128; ++n) { const float gv = A.in[15][n * 512 + c];
            const f32x4 x0 = *(const LAS f32x4*)(act + (128 + n) * 8), x1 = *(const LAS f32x4*)(act + (128 + n) * 8 + 4);
#pragma unroll
            for (int k = 0; k < 4; ++k) { dg[k] += x0[k] * gv; dg[4 + k] += x1[k] * gv; } }
        float rp_p = 0.f, kp_p = 0.f, vp_p = 0.f;
        if ((tb & (SEQ - 1)) != 0) { const bf16* pp = P + (size_t)(tb - 1) * NINX; rp_p = bf2f(pp[C_RP + c]); kp_p = bf2f(pp[C_KP + c]); vp_p = bf2f(pp[C_VP + c]); }
#pragma unroll
        for (int tk = 0; tk < 8; ++tk) { const int t = tb + tk; const bf16* p = P + (size_t)t * NINX;
            const float rp = bf2f(p[C_RP + c]), kp = bf2f(p[C_KP + c]), vp = bf2f(p[C_VP + c]);
            const float r = rp + (rp_p - rp) * mu_r, k = kp + (kp_p - kp) * mu_k, v = vp + (vp_p - vp) * mu_v;
            rp_p = rp; kp_p = kp; vp_p = vp;
            const float xw = -(w0c + dw[tk]); const float sp = fmaxf(xw, 0.f) + log1pf(__expf(-fabsf(xw)));
            const float wl = -sp - 0.5f; const float decay = __expf(-__expf(wl));
            const float a = sigmoidf_(a0c + da[tk]);
            const float kkv = k * kkc; const float n2 = wave_sum(kkv * kkv); const float kk = kkv * (1.0f / sqrtf(fmaxf(n2, 1e-24f)));
            const float km = k * (1.f + (a - 1.f) * kac);
            const float cb = wave_sum(r * km * rkc);
            const size_t o = (size_t)t * DB + c;
            NW[o] = decay; NKK[o] = kk; NBB[o] = kk * a; NKM[o] = km; NVV[o] = v; NR[o] = r; GG[o] = (bf16)f2bf(dg[tk]);
            if (F.lane == 0) CB[(size_t)t * 8 + hd] = cb; }
        __syncthreads();
    }
}
__device__ __forceinline__ void rwkv_scan_naive(Frame& F, const Args& A, int chain) {
    const float* NW = (const float*)(F.ws + WS_NV); const float* NKK = NW + (size_t)T * DB; const float* NBB = NKK + (size_t)T * DB; const float* NKM = NBB + (size_t)T * DB; const float* NVV = NKM + (size_t)T * DB; const float* NR = NVV + (size_t)T * DB;
    const bf16* GG = (const bf16*)(F.ws + WS_GG); const float* CB = (const float*)(F.ws + WS_CB); bf16* Y = (bf16*)(F.ws + WS_YB) + (size_t)T * DB;
    if (F.wave != 0) return;
    LAS float* blk = (LAS float*)F.lds;
    const int b = chain >> 3, hd = chain & 7, lane = F.lane, ch = hd * 64 + lane;
    const float lnw = A.in[19][ch], lnb = A.in[20][ch];
    float s[64];
#pragma unroll
    for (int j = 0; j < 64; ++j) s[j] = 0.f;
    for (int t0 = b * SEQ; t0 < (b + 1) * SEQ; t0 += 16) {
#pragma unroll
        for (int tk = 0; tk < 16; ++tk) { const size_t o = (size_t)(t0 + tk) * DB + ch;
            blk[(tk * 5 + 0) * 64 + lane] = NW[o]; blk[(tk * 5 + 1) * 64 + lane] = NKK[o]; blk[(tk * 5 + 2) * 64 + lane] = NBB[o]; blk[(tk * 5 + 3) * 64 + lane] = NKM[o]; blk[(tk * 5 + 4) * 64 + lane] = NR[o]; }
        LDS_WAIT(); asm volatile("" ::: "memory");
        for (int tk = 0; tk < 16; ++tk) { const int t = t0 + tk; const size_t o = (size_t)t * DB + ch;
            const float v = NVV[o];
            const LAS f32x4* wv = (const LAS f32x4*)(blk + (tk * 5 + 0) * 64); const LAS f32x4* kv = (const LAS f32x4*)(blk + (tk * 5 + 1) * 64); const LAS f32x4* bv = (const LAS f32x4*)(blk + (tk * 5 + 2) * 64);
            const LAS f32x4* mv = (const LAS f32x4*)(blk + (tk * 5 + 3) * 64); const LAS f32x4* rv = (const LAS f32x4*)(blk + (tk * 5 + 4) * 64);
            float sa = 0.f;
#pragma unroll
            for (int j = 0; j < 16; ++j) { const f32x4 k4 = kv[j]; sa += s[4 * j] * k4[0] + s[4 * j + 1] * k4[1] + s[4 * j + 2] * k4[2] + s[4 * j + 3] * k4[3]; }
            sa = -sa; float y = 0.f;
#pragma unroll
            for (int j = 0; j < 16; ++j) { const f32x4 w4 = wv[j], b4 = bv[j], m4 = mv[j], r4 = rv[j];
#pragma unroll
                for (int e = 0; e < 4; ++e) { const float ns = s[4 * j + e] * w4[e] + sa * b4[e] + v * m4[e]; s[4 * j + e] = ns; y += ns * r4[e]; } }
            const float mu = wave_sum(y) * (1.f / 64.f); const float dlt = y - mu; const float var = wave_sum(dlt * dlt) * (1.f / 64.f);
            const float yn = dlt * (1.0f / sqrtf(var + GN_EPS)) * lnw + lnb;
            const float outv = (yn + CB[(size_t)t * 8 + hd] * v) * bf2f(GG[o]);
            Y[o] = (bf16)f2bf(outv); }
        LDS_WAIT(); asm volatile("" ::: "memory");
    }
}

__device__ __forceinline__ unsigned cvtpk(float lo, float hi) { f32x2_t v = {lo, hi}; bf16x2_t b = __builtin_convertvector(v, bf16x2_t); return __builtin_bit_cast(unsigned, b); }
__device__ __forceinline__ f32x16 mfma32(const u32x4 a, const u32x4 b, const f32x16 c) { return __builtin_amdgcn_mfma_f32_32x32x16_bf16(__builtin_bit_cast(bf16x8, a), __builtin_bit_cast(bf16x8, b), c, 0, 0, 0); }
__device__ __forceinline__ void swap32(unsigned& a, unsigned& b) { auto r = __builtin_amdgcn_permlane32_swap(a, b, false, false); a = r[0]; b = r[1]; }
__device__ __forceinline__ void swap4(u32x4& a, u32x4& b) { unsigned a0 = a.x, a1 = a.y, a2 = a.z, a3 = a.w, b0 = b.x, b1 = b.y, b2 = b.z, b3 = b.w; swap32(a0, b0); swap32(a1, b1); swap32(a2, b2); swap32(a3, b3); a = (u32x4){a0, a1, a2, a3}; b = (u32x4){b0, b1, b2, b3}; }
#define F16Z ((f32x16){0.f, 0.f, 0.f, 0.f, 0.f, 0.f, 0.f, 0.f, 0.f, 0.f, 0.f, 0.f, 0.f, 0.f, 0.f, 0.f})
#define PACKC(c, sp) ((u32x4){cvtpk((c)[8 * (sp) + 0], (c)[8 * (sp) + 1]), cvtpk((c)[8 * (sp) + 2], (c)[8 * (sp) + 3]), cvtpk((c)[8 * (sp) + 4], (c)[8 * (sp) + 5]), cvtpk((c)[8 * (sp) + 6], (c)[8 * (sp) + 7])})
#define CROW0(reg) (((reg) & 3) + 8 * ((reg) >> 2))
__device__ __forceinline__ void load_rowfrags(const bf16* Xrm, int lane, u32x4 (&Fr)[2][4]) {
    const bf16* row = Xrm + lane * 256;
#pragma unroll
    for (int g = 0; g < 4; ++g) { const u32x2 a0 = *(const GAS u32x2*)(row + 16 * g), b0 = *(const GAS u32x2*)(row + 16 * g + 4), a1 = *(const GAS u32x2*)(row + 16 * g + 8), b1 = *(const GAS u32x2*)(row + 16 * g + 12);
        u32x4 P0 = {a0.x, a0.y, a1.x, a1.y}, P1 = {b0.x, b0.y, b1.x, b1.y};
        swap4(P0, P1);
        Fr[0][g] = P0; Fr[1][g] = P1; }
}
#define BLOB_ST(base, cidx, f, val) (*(GAS u32x4*)((base) + ((size_t)(cidx) * 8 + (f)) * 1024 + lane * 16) = (val))
#define BLOB_LD(base, cidx, f) (*(const GAS u32x4*)((base) + ((size_t)(cidx) * 8 + (f)) * 1024 + lane * 16))

__device__ __forceinline__ void rwkv_chunk_job(Frame& F, const Args& A, int job) {
    const bf16* P = (const bf16*)(F.ws + WS_P);
    int lane_ = F.lane; asm volatile("" : "+v"(lane_));
    const int lane = lane_, hd = F.wave, tid = hd * 64 + lane, r = lane & 31, h = lane >> 5, t0 = job * 64, c = hd * 64 + lane;
    const bool bstart = (t0 & (SEQ - 1)) == 0;
    LAS unsigned char* actb = F.lds;
    { const int t = tid >> 3, n0 = (tid & 7) * 32; const bf16* pa = P + (size_t)(t0 + t) * NINX + C_LA + n0; const bool hasprev = !(bstart && t == 0);
      const bf16* pb = P + (size_t)(t0 + t - (hasprev ? 1 : 0)) * NINX + C_LB + n0;
#pragma unroll
      for (int q = 0; q < 4; ++q) { const u32x4 wa = *(const GAS u32x4*)(pa + 8 * q); u32x4 wb = *(const GAS u32x4*)(pb + 8 * q); if (!hasprev) wb = (u32x4){0u, 0u, 0u, 0u};
          float v[8]; v[0] = bflo(wa.x) + bflo(wb.x); v[1] = bfhi(wa.x) + bfhi(wb.x); v[2] = bflo(wa.y) + bflo(wb.y); v[3] = bfhi(wa.y) + bfhi(wb.y); v[4] = bflo(wa.z) + bflo(wb.z); v[5] = bfhi(wa.z) + bfhi(wb.z); v[6] = bflo(wa.w) + bflo(wb.w); v[7] = bfhi(wa.w) + bfhi(wb.w);
#pragma unroll
          for (int e = 0; e < 8; ++e) { if (n0 < 64) v[e] = tanhf(v[e]); else if (n0 >= 128) v[e] = sigmoidf_(v[e]); }
          *(LAS u32x4*)(actb + ((size_t)t * 264 + n0 + 8 * q) * 2) = (u32x4){cvtpk(v[0], v[1]), cvtpk(v[2], v[3]), cvtpk(v[4], v[5]), cvtpk(v[6], v[7])}; } }
    {
      unsigned acc_ = 0u;
#pragma unroll
      for (int q = 0; q < 24; ++q) { const int ch = tid + 512 * q; const int row = ch / 192, col = ch - row * 192; const u32x4 w = *(const GAS u32x4*)(P + (size_t)(t0 + row) * NINX + C_RP + col * 8); acc_ ^= w.x ^ w.y ^ w.z ^ w.w; }
      asm volatile("" :: "v"(acc_)); }
    __syncthreads();
    const bf16* W2T = (const bf16*)(F.ws + WS_W2T); const bf16* A2T = (const bf16*)(F.ws + WS_A2T); const bf16* G2T = (const bf16*)(F.ws + WS_G2T);
    bf16* GG = (bf16*)(F.ws + WS_GG); float* CB = (float*)(F.ws + WS_CB); float* GC = (float*)(F.ws + WS_GC);
    { f32x16 ag[2][2];
#pragma unroll
      for (int mt = 0; mt < 2; ++mt)
#pragma unroll
          for (int nt = 0; nt < 2; ++nt) ag[mt][nt] = F16Z;
#pragma unroll
      for (int ks = 0; ks < 8; ++ks) { u32x4 af[2];
#pragma unroll
          for (int mt = 0; mt < 2; ++mt) af[mt] = *(const LAS u32x4*)(actb + ((size_t)(32 * mt + r) * 264 + 128 + 16 * ks + 8 * h) * 2);
#pragma unroll
          for (int nt = 0; nt < 2; ++nt) { const u32x4 bfr = *(const GAS u32x4*)(G2T + (size_t)(hd * 64 + 32 * nt + r) * 128 + 16 * ks + 8 * h);
#pragma unroll
              for (int mt = 0; mt < 2; ++mt) ag[mt][nt] = mfma32(af[mt], bfr, ag[mt][nt]); } }
#pragma unroll
      for (int mt = 0; mt < 2; ++mt)
#pragma unroll
          for (int nt = 0; nt < 2; ++nt)
#pragma unroll
              for (int reg = 0; reg < 16; ++reg) GG[(size_t)(t0 + 32 * mt + CROW0(reg) + 4 * h) * DB + hd * 64 + 32 * nt + r] = (bf16)f2bf(ag[mt][nt][reg]); }
    float lw_[64], av_[64];
    { f32x16 aw[2][2], aa[2][2];
#pragma unroll
      for (int mt = 0; mt < 2; ++mt)
#pragma unroll
          for (int nt = 0; nt < 2; ++nt) { aw[mt][nt] = F16Z; aa[mt][nt] = F16Z; }
#pragma unroll
      for (int ks = 0; ks < 4; ++ks) { u32x4 afw[2], afa[2];
#pragma unroll
          for (int mt = 0; mt < 2; ++mt) { afw[mt] = *(const LAS u32x4*)(actb + ((size_t)(32 * mt + r) * 264 + 16 * ks + 8 * h) * 2); afa[mt] = *(const LAS u32x4*)(actb + ((size_t)(32 * mt + r) * 264 + 64 + 16 * ks + 8 * h) * 2); }
#pragma unroll
          for (int nt = 0; nt < 2; ++nt) { const u32x4 bw = *(const GAS u32x4*)(W2T + (size_t)(hd * 64 + 32 * nt + r) * 64 + 16 * ks + 8 * h), ba = *(const GAS u32x4*)(A2T + (size_t)(hd * 64 + 32 * nt + r) * 64 + 16 * ks + 8 * h);
#pragma unroll
              for (int mt = 0; mt < 2; ++mt) { aw[mt][nt] = mfma32(afw[mt], bw, aw[mt][nt]); aa[mt][nt] = mfma32(afa[mt], ba, aa[mt][nt]); } } }
      const float w0c = A.in[10][c], a0c = A.in[13][c];
#pragma unroll
      for (int mt = 0; mt < 2; ++mt)
#pragma unroll
          for (int reg = 0; reg < 16; ++reg) { const float fx = aw[mt][0][reg], fy = aw[mt][1][reg], fp = aa[mt][0][reg], fq = aa[mt][1][reg];
              unsigned x = __float_as_uint(fx), y = __float_as_uint(fy); swap32(x, y);
              unsigned p = __float_as_uint(fp), q = __float_as_uint(fq); swap32(p, q);
              const int tA = 32 * mt + CROW0(reg);
              { const float xw = -(w0c + __builtin_bit_cast(float, x)); const float sp = fmaxf(xw, 0.f) + log1pf(__expf(-fabsf(xw))); lw_[tA] = -__expf(-sp - 0.5f); }
              { const float xw = -(w0c + __builtin_bit_cast(float, y)); const float sp = fmaxf(xw, 0.f) + log1pf(__expf(-fabsf(xw))); lw_[tA + 4] = -__expf(-sp - 0.5f); }
              av_[tA] = sigmoidf_(a0c + __builtin_bit_cast(float, p)); av_[tA + 4] = sigmoidf_(a0c + __builtin_bit_cast(float, q)); } }
    bf16* sb = (bf16*)(F.ws + WS_S2) + ((size_t)job * 8 + hd) * 32768; bf16* sbr = sb + 16384;
    { const float mu_r = A.in[6][c], mu_k = A.in[6][512 + c], mu_v = A.in[6][1024 + c], kkc = A.in[16][c], kac = A.in[17][c], rkc = A.in[18][c];
      float rp_p = 0.f, kp_p = 0.f, vp_p = 0.f, cum = 0.f;
      if (!bstart) { const bf16* pp = P + (size_t)(t0 - 1) * NINX; rp_p = bf2f(pp[C_RP + c]); kp_p = bf2f(pp[C_KP + c]); vp_p = bf2f(pp[C_VP + c]); }
      unsigned pkA[4], pkB[4], pkK[4], pkV[4]; float hA = 0.f, hB = 0.f, hK = 0.f, hV = 0.f, cbv = 0.f;
      const GAS bf16* pl = (const GAS bf16*)(P + (size_t)t0 * NINX + C_KP + c);
      GAS bf16* ps = (GAS bf16*)(sb + lane); GAS bf16* pr = (GAS bf16*)(sbr + lane * 256); GAS float* pcb = (GAS float*)(CB + (size_t)t0 * 8 + hd);
      unsigned short qr[4], qk[4], qv[4];
#pragma unroll
      for (int i = 0; i < 4; ++i) { qr[i] = pl[(size_t)i * NINX - 512]; qk[i] = pl[(size_t)i * NINX]; qv[i] = pl[(size_t)i * NINX + 512]; }
      pl += 4 * NINX;
#pragma unroll
      for (int t = 0; t < 64; ++t) {
          if ((t & 15) == 0) asm volatile("" : "+v"(pl), "+v"(ps));
          const float rp = bf2f(qr[t & 3]), kp = bf2f(qk[t & 3]), vp = bf2f(qv[t & 3]);
          if (t + 4 < 64) { qr[t & 3] = pl[-512]; qk[t & 3] = pl[0]; qv[t & 3] = pl[512]; }
          const float r_ = rp + (rp_p - rp) * mu_r, k_ = kp + (kp_p - kp) * mu_k, v_ = vp + (vp_p - vp) * mu_v; rp_p = rp; kp_p = kp; vp_p = vp;
          const float a = av_[t];
          const float kkv = k_ * kkc; const float n2 = wave_sum_dpp(kkv * kkv); const float kk = kkv * __builtin_amdgcn_rsqf(fmaxf(n2, 1e-24f));
          const float km = k_ * (1.f + (a - 1.f) * kac);
          const float cb = wave_sum_dpp(r_ * km * rkc); cbv = (lane == t) ? cb : cbv;
          const float gp = __expf(cum); cum += lw_[t]; const float g = __expf(cum), ig = __expf(-cum);
          const float vA = -kk * gp, vB = kk * a * ig, vK = km * ig, vR = r_ * g;
          { const unsigned ab = cvtpk(vA, vB), kr = cvtpk(vK, vR); ps[0] = (bf16)(ab & 0xffffu); ps[64] = (bf16)(ab >> 16); ps[128] = (bf16)(kr & 0xffffu); ps[192] = (bf16)(kr >> 16); }
          if ((t & 1) == 0) { hA = vA; hB = vB; hK = vK; hV = v_; }
          else { pkA[(t & 7) >> 1] = cvtpk(hA, vA); pkB[(t & 7) >> 1] = cvtpk(hB, vB); pkK[(t & 7) >> 1] = cvtpk(hK, vK); pkV[(t & 7) >> 1] = cvtpk(hV, v_); }
          if ((t & 7) == 7) { const int o = t - 7;
              *(GAS u32x4*)(pr + o) = (u32x4){pkA[0], pkA[1], pkA[2], pkA[3]}; *(GAS u32x4*)(pr + 64 + o) = (u32x4){pkB[0], pkB[1], pkB[2], pkB[3]};
              *(GAS u32x4*)(pr + 128 + o) = (u32x4){pkK[0], pkK[1], pkK[2], pkK[3]}; *(GAS u32x4*)(pr + 192 + o) = (u32x4){pkV[0], pkV[1], pkV[2], pkV[3]}; }
          pl += NINX; ps += 256; }
      pcb[lane * 8] = cbv;
      GC[((size_t)job * 8 + hd) * 64 + lane] = __expf(cum); }
    VM_WAIT();
    __syncthreads();
    const bf16 *At_tm = sb, *Bt_tm = sb + 64, *Kt_tm = sb + 128, *Rt_tm = sb + 192, *At_rm = sbr, *Bt_rm = sbr + 64, *Kt_rm = sbr + 128, *V_rm = sbr + 192;
#define FRAG_TM(X, tile, ks) (*(const GAS u32x4*)((X) + (32 * (tile) + r) * 256 + 16 * (ks) + 8 * h))
    LAS float* NT = (LAS float*)(F.lds + F.wave * 17408);
    const int cidx = job * 8 + hd;
    unsigned char* outb = (unsigned char*)F.out;
    const float gC0 = GC[(size_t)cidx * 64 + r], gC1 = GC[(size_t)cidx * 64 + 32 + r];
    u32x4 P2[2][2][2], P3[2][2][2];
    { u32x4 Af[2][4], Bf[2][4];
#pragma unroll
      for (int tl = 0; tl < 2; ++tl)
#pragma unroll
          for (int ks = 0; ks < 4; ++ks) { Af[tl][ks] = FRAG_TM(At_tm, tl, ks); Bf[tl][ks] = FRAG_TM(Bt_tm, tl, ks); }
#pragma unroll
      for (int mt = 0; mt < 2; ++mt)
#pragma unroll
          for (int nt = 0; nt < 2; ++nt) { if (mt == 1 && nt == 0) continue; f32x16 acc = F16Z;
#pragma unroll
              for (int ks = 0; ks < 4; ++ks) acc = mfma32(Bf[mt][ks], Af[nt][ks], acc);
#pragma unroll
              for (int g4 = 0; g4 < 4; ++g4) *(LAS f32x4*)(NT + (32 * nt + r) * 68 + 32 * mt + 8 * g4 + 4 * h) = (f32x4){acc[4 * g4], acc[4 * g4 + 1], acc[4 * g4 + 2], acc[4 * g4 + 3]}; }
      { u32x4 Kf[2][4];
#pragma unroll
        for (int tl = 0; tl < 2; ++tl)
#pragma unroll
            for (int ks = 0; ks < 4; ++ks) Kf[tl][ks] = FRAG_TM(Kt_tm, tl, ks);
#pragma unroll
        for (int mt = 0; mt < 2; ++mt)
#pragma unroll
            for (int nt = 0; nt < 2; ++nt) { f32x16 acc = F16Z;
                if (!(mt == 0 && nt == 1)) {
#pragma unroll
                    for (int ks = 0; ks < 4; ++ks) acc = mfma32(Af[mt][ks], Kf[nt][ks], acc);
                    if (mt == nt) {
#pragma unroll
                        for (int reg = 0; reg < 16; ++reg) acc[reg] = (r < CROW0(reg) + 4 * h) ? acc[reg] : 0.f; } }
                P2[mt][nt][0] = PACKC(acc, 0); P2[mt][nt][1] = PACKC(acc, 1); } }
      { u32x4 Rf[2][4];
#pragma unroll
        for (int tl = 0; tl < 2; ++tl)
#pragma unroll
            for (int ks = 0; ks < 4; ++ks) Rf[tl][ks] = FRAG_TM(Rt_tm, tl, ks);
#pragma unroll
        for (int mt = 0; mt < 2; ++mt)
#pragma unroll
            for (int nt = 0; nt < 2; ++nt) { f32x16 acc = F16Z;
                if (!(mt == 1 && nt == 0)) {
#pragma unroll
                    for (int ks = 0; ks < 4; ++ks) acc = mfma32(Bf[mt][ks], Rf[nt][ks], acc);
                    if (mt == nt) {
#pragma unroll
                        for (int reg = 0; reg < 16; ++reg) acc[reg] = (CROW0(reg) + 4 * h <= r) ? acc[reg] : 0.f; } }
                P3[mt][nt][0] = PACKC(acc, 0); P3[mt][nt][1] = PACKC(acc, 1); } } }
    LDS_WAIT(); asm volatile("" ::: "memory");
    u32x4 TA[2][4];
    { float Tr[64];
#pragma unroll
      for (int t = 0; t < 64; ++t) { float col = (lane == t) ? 1.f : 0.f;
#pragma unroll
          for (int q = 0; q < (t + 3) / 4; ++q) { const f32x4 nv = *(const LAS f32x4*)(NT + t * 68 + 4 * q);
#pragma unroll
              for (int e = 0; e < 4; ++e) if (4 * q + e < t) col += Tr[4 * q + e] * nv[e]; }
          Tr[t] = col; }
#pragma unroll
      for (int g = 0; g < 4; ++g) { u32x4 P0 = {cvtpk(Tr[16 * g], Tr[16 * g + 1]), cvtpk(Tr[16 * g + 2], Tr[16 * g + 3]), cvtpk(Tr[16 * g + 8], Tr[16 * g + 9]), cvtpk(Tr[16 * g + 10], Tr[16 * g + 11])};
          u32x4 P1 = {cvtpk(Tr[16 * g + 4], Tr[16 * g + 5]), cvtpk(Tr[16 * g + 6], Tr[16 * g + 7]), cvtpk(Tr[16 * g + 12], Tr[16 * g + 13]), cvtpk(Tr[16 * g + 14], Tr[16 * g + 15])};
          swap4(P0, P1); TA[0][g] = P0; TA[1][g] = P1; } }
    u32x4 P5a[2][2][2], P5b[2][2][2];
    { u32x4 BB[2][4]; load_rowfrags(Bt_rm, lane, BB);
#pragma unroll
      for (int mt = 0; mt < 2; ++mt)
#pragma unroll
          for (int nt = 0; nt < 2; ++nt) { f32x16 acc = F16Z;
#pragma unroll
              for (int g = 0; g < 4; ++g) { if ((g >> 1) == 1 && nt == 0) continue; acc = mfma32(TA[mt][g], P3[g >> 1][nt][g & 1], acc); }
              P5a[mt][nt][0] = PACKC(acc, 0); P5a[mt][nt][1] = PACKC(acc, 1);
              acc = F16Z;
#pragma unroll
              for (int g = 0; g < 4; ++g) acc = mfma32(TA[mt][g], BB[nt][g], acc);
              P5b[mt][nt][0] = PACKC(acc, 0); P5b[mt][nt][1] = PACKC(acc, 1); } }
    u32x4 Q2P[2][2][2], HP[2][2][2];
    { u32x4 Kf[2][4], Rf[2][4];
#pragma unroll
      for (int tl = 0; tl < 2; ++tl)
#pragma unroll
          for (int ks = 0; ks < 4; ++ks) { Kf[tl][ks] = FRAG_TM(Kt_tm, tl, ks); Rf[tl][ks] = FRAG_TM(Rt_tm, tl, ks); }
#pragma unroll
      for (int mt = 0; mt < 2; ++mt)
#pragma unroll
          for (int nt = 0; nt < 2; ++nt) { f32x16 acc = F16Z;
              if (!(mt == 1 && nt == 0)) {
#pragma unroll
                  for (int ks = 0; ks < 4; ++ks) acc = mfma32(Kf[mt][ks], Rf[nt][ks], acc);
                  if (mt == nt) {
#pragma unroll
                      for (int reg = 0; reg < 16; ++reg) acc[reg] = (CROW0(reg) + 4 * h <= r) ? acc[reg] : 0.f; } }
#pragma unroll
              for (int m2 = 0; m2 < 2; ++m2)
#pragma unroll
                  for (int sp = 0; sp < 2; ++sp) { if (m2 == 0 && mt == 1) continue; acc = mfma32(P2[m2][mt][sp], P5a[m2][nt][sp], acc); }
              Q2P[mt][nt][0] = PACKC(acc, 0); Q2P[mt][nt][1] = PACKC(acc, 1); } }
#pragma unroll
    for (int mt = 0; mt < 2; ++mt)
#pragma unroll
        for (int nt = 0; nt < 2; ++nt) { f32x16 acc;
#pragma unroll
            for (int g4 = 0; g4 < 4; ++g4) { const u32x2 kv = *(const GAS u32x2*)(Kt_rm + (32 * nt + r) * 256 + 32 * mt + 8 * g4 + 4 * h); acc[4 * g4] = bflo(kv.x); acc[4 * g4 + 1] = bfhi(kv.x); acc[4 * g4 + 2] = bflo(kv.y); acc[4 * g4 + 3] = bfhi(kv.y); }
#pragma unroll
            for (int m2 = 0; m2 < 2; ++m2)
#pragma unroll
                for (int sp = 0; sp < 2; ++sp) { if (m2 == 0 && mt == 1) continue; acc = mfma32(P2[m2][mt][sp], P5b[m2][nt][sp], acc); }
            const float gc = nt ? gC1 : gC0;
#pragma unroll
            for (int reg = 0; reg < 16; ++reg) acc[reg] *= gc;
            HP[mt][nt][0] = PACKC(acc, 0); HP[mt][nt][1] = PACKC(acc, 1); }
    { u32x4 VB[2][4]; load_rowfrags(V_rm, lane, VB);
#pragma unroll
      for (int mt = 0; mt < 2; ++mt)
#pragma unroll
          for (int nt = 0; nt < 2; ++nt) { f32x16 acc = F16Z;
#pragma unroll
              for (int m2 = 0; m2 < 2; ++m2)
#pragma unroll
                  for (int sp = 0; sp < 2; ++sp) acc = mfma32(HP[m2][mt][sp], VB[nt][2 * m2 + sp], acc);
              BLOB_ST(F.ws + WS_BD, cidx, (mt * 2 + nt) * 2 + 0, PACKC(acc, 0)); BLOB_ST(F.ws + WS_BD, cidx, (mt * 2 + nt) * 2 + 1, PACKC(acc, 1));
              acc = F16Z;
#pragma unroll
              for (int g = 0; g < 4; ++g) { if ((g >> 1) == 1 && nt == 0) continue; acc = mfma32(VB[mt][g], Q2P[g >> 1][nt][g & 1], acc); }
              BLOB_ST(outb + OUT_BYL, cidx, (mt * 2 + nt) * 2 + 0, PACKC(acc, 0)); BLOB_ST(outb + OUT_BYL, cidx, (mt * 2 + nt) * 2 + 1, PACKC(acc, 1)); } }
    { u32x4 AA[2][4]; load_rowfrags(At_rm, lane, AA);
#pragma unroll
      for (int mt = 0; mt < 2; ++mt)
#pragma unroll
          for (int nt = 0; nt < 2; ++nt) { f32x16 acc;
#pragma unroll
              for (int g4 = 0; g4 < 4; ++g4) { const u32x2 rv = *(const GAS u32x2*)(Rt_tm + (32 * nt + r) * 256 + 32 * mt + 8 * g4 + 4 * h); acc[4 * g4] = bflo(rv.x); acc[4 * g4 + 1] = bfhi(rv.x); acc[4 * g4 + 2] = bflo(rv.y); acc[4 * g4 + 3] = bfhi(rv.y); }
#pragma unroll
              for (int g = 0; g < 4; ++g) acc = mfma32(AA[mt][g], P5a[g >> 1][nt][g & 1], acc);
              BLOB_ST(outb + OUT_BQ1, cidx, (mt * 2 + nt) * 2 + 0, PACKC(acc, 0)); BLOB_ST(outb + OUT_BQ1, cidx, (mt * 2 + nt) * 2 + 1, PACKC(acc, 1));
              acc = F16Z;
#pragma unroll
              for (int g = 0; g < 4; ++g) acc = mfma32(AA[mt][g], P5b[g >> 1][nt][g & 1], acc);
              const float gc = nt ? gC1 : gC0;
#pragma unroll
              for (int reg = 0; reg < 16; ++reg) { float x = acc[reg]; if (mt == nt) x += (CROW0(reg) + 4 * h == r) ? 1.f : 0.f; acc[reg] = x * gc; }
              BLOB_ST(outb + OUT_BG, cidx, (mt * 2 + nt) * 2 + 0, PACKC(acc, 0)); BLOB_ST(outb + OUT_BG, cidx, (mt * 2 + nt) * 2 + 1, PACKC(acc, 1)); } }
#undef FRAG_TM
    __syncthreads();
}

constexpr int CH_SLOTS = 8, CH_SLOT_BYTES = 16384;
__device__ __forceinline__ void rwkv_chain_wg(Frame& F, int chain) {
    const int lane = F.lane, b = chain >> 3, hd = chain & 7, wave = F.wave;
    unsigned char* outb = (unsigned char*)F.out;
    volatile LAS unsigned* ready = F.MISC + 64;
    volatile LAS unsigned* done = F.MISC + 72;
    if (wave >= 2) {
        for (int base = (wave - 2) * 3; base < 128; base += 18) {
            u32x4 g[3][16];
#pragma unroll
            for (int k = 0; k < 3; ++k) { const int ch = base + k; const int cidx = (b * 128 + (ch < 128 ? ch : 127)) * 8 + hd;
#pragma unroll
                for (int f = 0; f < 8; ++f) { g[k][f] = BLOB_LD(outb + OUT_BG, cidx, f); g[k][8 + f] = BLOB_LD(F.ws + WS_BD, cidx, f); } }
#pragma unroll
            for (int k = 0; k < 3; ++k) { const int ch = base + k; if (ch >= 128) break;
                const int slot = ch % CH_SLOTS; const unsigned need = (unsigned)(ch / CH_SLOTS);
                while (done[slot] < need || done[8 + slot] < need) __builtin_amdgcn_s_sleep(2);
                LAS unsigned char* sl = F.lds + slot * CH_SLOT_BYTES + lane * 16;
#pragma unroll
                for (int f = 0; f < 16; ++f) *(LAS u32x4*)(sl + f * 1024) = g[k][f];
                LDS_WAIT(); asm volatile("" ::: "memory");
                if (lane == 0) ready[slot] = need + 1u; }
        }
    } else {
        const int nt = wave;
        f32x16 st[2] = {F16Z, F16Z};
        for (int ch = 0; ch < 128; ++ch) { const int slot = ch % CH_SLOTS; const unsigned need = (unsigned)(ch / CH_SLOTS) + 1u; const int cidx = (b * 128 + ch) * 8 + hd;
            u32x4 SP[2][2];
#pragma unroll
            for (int m2 = 0; m2 < 2; ++m2) { SP[m2][0] = PACKC(st[m2], 0); SP[m2][1] = PACKC(st[m2], 1);
                BLOB_ST(outb + OUT_BS, cidx, (m2 * 2 + nt) * 2 + 0, SP[m2][0]); BLOB_ST(outb + OUT_BS, cidx, (m2 * 2 + nt) * 2 + 1, SP[m2][1]); }
            while (ready[slot] < need) __builtin_amdgcn_s_sleep(1);
            asm volatile("" ::: "memory");
            const LAS unsigned char* sl = F.lds + slot * CH_SLOT_BYTES + lane * 16;
            u32x4 g_[8]; f32x16 acc[2];
#pragma unroll
            for (int f = 0; f < 8; ++f) g_[f] = *(const LAS u32x4*)(sl + f * 1024);
#pragma unroll
            for (int mt = 0; mt < 2; ++mt)
#pragma unroll
                for (int sp = 0; sp < 2; ++sp) { const u32x4 w = *(const LAS u32x4*)(sl + 8192 + ((mt * 2 + nt) * 2 + sp) * 1024);
                    acc[mt][8 * sp + 0] = bflo(w.x); acc[mt][8 * sp + 1] = bfhi(w.x); acc[mt][8 * sp + 2] = bflo(w.y); acc[mt][8 * sp + 3] = bfhi(w.y); acc[mt][8 * sp + 4] = bflo(w.z); acc[mt][8 * sp + 5] = bfhi(w.z); acc[mt][8 * sp + 6] = bflo(w.w); acc[mt][8 * sp + 7] = bfhi(w.w); }
            LDS_WAIT(); asm volatile("" ::: "memory");
            if (lane == 0) done[nt * 8 + slot] = need;
#pragma unroll
            for (int mt = 0; mt < 2; ++mt)
#pragma unroll
                for (int m2 = 0; m2 < 2; ++m2)
#pragma unroll
                    for (int sp = 0; sp < 2; ++sp) acc[mt] = mfma32(g_[(m2 * 2 + mt) * 2 + sp], SP[m2][sp], acc[mt]);
            st[0] = acc[0]; st[1] = acc[1]; }
    }
}

__device__ __forceinline__ void rwkv_out(Frame& F, const Args& A, int cidx) {
    const bf16* P = (const bf16*)(F.ws + WS_P); const bf16* GG = (const bf16*)(F.ws + WS_GG); const float* CB = (const float*)(F.ws + WS_CB); bf16* Y = (bf16*)(F.ws + WS_YB) + (size_t)T * DB;
    int lane_ = F.lane; asm volatile("" : "+v"(lane_));
    const int lane = lane_, r = lane & 31, h = lane >> 5, job = cidx >> 3, hd = cidx & 7, t0 = job * 64;
    const bool bstart = (t0 & (SEQ - 1)) == 0;
    const unsigned char* outb = (const unsigned char*)F.out;
    u32x4 SP[8], Q1[8];
#pragma unroll
    for (int f = 0; f < 8; ++f) { SP[f] = BLOB_LD(outb + OUT_BS, cidx, f); Q1[f] = BLOB_LD(outb + OUT_BQ1, cidx, f); }
    f32x16 y[2][2];
#pragma unroll
    for (int mt = 0; mt < 2; ++mt)
#pragma unroll
        for (int nt = 0; nt < 2; ++nt) { f32x16 acc;
#pragma unroll
            for (int sp = 0; sp < 2; ++sp) { const u32x4 w = BLOB_LD(outb + OUT_BYL, cidx, (mt * 2 + nt) * 2 + sp);
                acc[8 * sp + 0] = bflo(w.x); acc[8 * sp + 1] = bfhi(w.x); acc[8 * sp + 2] = bflo(w.y); acc[8 * sp + 3] = bfhi(w.y); acc[8 * sp + 4] = bflo(w.z); acc[8 * sp + 5] = bfhi(w.z); acc[8 * sp + 6] = bflo(w.w); acc[8 * sp + 7] = bfhi(w.w); }
#pragma unroll
            for (int m2 = 0; m2 < 2; ++m2)
#pragma unroll
                for (int sp = 0; sp < 2; ++sp) acc = mfma32(SP[(m2 * 2 + mt) * 2 + sp], Q1[(m2 * 2 + nt) * 2 + sp], acc);
            y[mt][nt] = acc; }
#pragma unroll
    for (int nt = 0; nt < 2; ++nt) { const int t = t0 + 32 * nt + r;
        float s1 = 0.f;
#pragma unroll
        for (int mt = 0; mt < 2; ++mt)
#pragma unroll
            for (int reg = 0; reg < 16; ++reg) s1 += y[mt][nt][reg];
        s1 += __shfl_xor(s1, 32); const float mu = s1 * (1.f / 64.f); float s2 = 0.f;
#pragma unroll
        for (int mt = 0; mt < 2; ++mt)
#pragma unroll
            for (int reg = 0; reg < 16; ++reg) { const float d = y[mt][nt][reg] - mu; s2 += d * d; }
        s2 += __shfl_xor(s2, 32); const float rstd = 1.0f / sqrtf(s2 * (1.f / 64.f) + GN_EPS);
        const float cb = CB[(size_t)t * 8 + hd]; const bool hasprev = !(bstart && nt == 0 && r == 0);
        const bf16* pv = P + (size_t)t * NINX + C_VP + hd * 64; const bf16* pvp = P + (size_t)(t - (hasprev ? 1 : 0)) * NINX + C_VP + hd * 64;
#pragma unroll
        for (int mt = 0; mt < 2; ++mt)
#pragma unroll
            for (int g4 = 0; g4 < 4; ++g4) { const int i0 = 32 * mt + 8 * g4 + 4 * h;
                const f32x4 lw = *(const GAS f32x4*)(A.in[19] + hd * 64 + i0), lb = *(const GAS f32x4*)(A.in[20] + hd * 64 + i0), mv = *(const GAS f32x4*)(A.in[6] + 1024 + hd * 64 + i0);
                const u32x2 v0 = *(const GAS u32x2*)(pv + i0); u32x2 v1 = *(const GAS u32x2*)(pvp + i0); if (!hasprev) v1 = (u32x2){0u, 0u};
                const u32x2 gg = *(const GAS u32x2*)(GG + (size_t)t * DB + hd * 64 + i0);
                float vv[4], vp_[4], gv[4]; vv[0] = bflo(v0.x); vv[1] = bfhi(v0.x); vv[2] = bflo(v0.y); vv[3] = bfhi(v0.y); vp_[0] = bflo(v1.x); vp_[1] = bfhi(v1.x); vp_[2] = bflo(v1.y); vp_[3] = bfhi(v1.y);
                gv[0] = bflo(gg.x); gv[1] = bfhi(gg.x); gv[2] = bflo(gg.y); gv[3] = bfhi(gg.y);
                float o[4];
#pragma unroll
                for (int e = 0; e < 4; ++e) { const float v = vv[e] + (vp_[e] - vv[e]) * mv[e]; o[e] = ((y[mt][nt][4 * g4 + e] - mu) * rstd * lw[e] + lb[e] + cb * v) * gv[e]; }
                *(GAS u32x2*)(Y + (size_t)t * DB + hd * 64 + i0) = (u32x2){cvtpk(o[0], o[1]), cvtpk(o[2], o[3])}; } }
}

__device__ __forceinline__ void router_job(Frame& F, const Args& A, int job) {
    const float* X2 = F.out; bf16* H2 = (bf16*)(F.ws + WS_H); const bf16* RH = (const bf16*)(F.ws + WS_RTHI); const bf16* RL = (const bf16*)(F.ws + WS_RTLO);
    int* ROUTE = (int*)(F.ws + WS_ROUTE); float* COMB = (float*)(F.ws + WS_ROUTE + 512 * 1024); int* LIST = (int*)(F.ws + WS_LIST); unsigned* CNT = (unsigned*)(F.ctl + CW_CNT);
    LAS float* rinv_s = (LAS float*)(F.lds + 90112);
    LAS float* part = (LAS float*)F.lds;
    int lane_ = F.lane; asm volatile("" : "+v"(lane_));
    const int lane = lane_, wave = F.wave, row = lane & 15, q = lane >> 4, tb = job * 64;
#pragma unroll
    for (int i = 0; i < 8; ++i) { const GAS f32x4* xr = (const GAS f32x4*)(X2 + (size_t)(tb + 8 * wave + i) * D) + lane; float ss = 0.f;
#pragma unroll
        for (int j = 0; j < 4; ++j) { const f32x4 v = xr[64 * j]; ss += (v.x * v.x + v.y * v.y) + (v.z * v.z + v.w * v.w); }
        ss = wave_sum(ss); if (lane == 0) rinv_s[8 * wave + i] = 1.0f / sqrtf(ss * (1.f / D) + NORM_EPS); }
    __syncthreads();
    f32x4 acc[4][5];
#pragma unroll
    for (int mt = 0; mt < 4; ++mt)
#pragma unroll
        for (int nt = 0; nt < 5; ++nt) acc[mt][nt] = (f32x4){0.f, 0.f, 0.f, 0.f};
    float rv[4];
#pragma unroll
    for (int mt = 0; mt < 4; ++mt) rv[mt] = rinv_s[16 * mt + row];
#pragma unroll
    for (int ks = 0; ks < 4; ++ks) { const int k0 = 128 * wave + 32 * ks + 8 * q;
        bf16x8 bh[5], bl[5];
#pragma unroll
        for (int nt = 0; nt < 5; ++nt) { const size_t wo = (size_t)(16 * nt + row) * 1024 + k0; bh[nt] = *(const GAS bf16x8*)(RH + wo); bl[nt] = *(const GAS bf16x8*)(RL + wo); }
        const f32x4 ga = *(const GAS f32x4*)(A.in[26] + k0), gb = *(const GAS f32x4*)(A.in[26] + k0 + 4);
#pragma unroll
        for (int mt = 0; mt < 4; ++mt) { const float* xr = X2 + (size_t)(tb + 16 * mt + row) * D + k0; const f32x4 a = *(const GAS f32x4*)(xr), b = *(const GAS f32x4*)(xr + 4); const float ri = rv[mt];
            float hv[8]; hv[0] = a.x * ri * ga.x; hv[1] = a.y * ri * ga.y; hv[2] = a.z * ri * ga.z; hv[3] = a.w * ri * ga.w; hv[4] = b.x * ri * gb.x; hv[5] = b.y * ri * gb.y; hv[6] = b.z * ri * gb.z; hv[7] = b.w * ri * gb.w;
            unsigned hi[8], lo[8];
#pragma unroll
            for (int e = 0; e < 8; ++e) { hi[e] = f2bf(hv[e]); lo[e] = f2bf(hv[e] - bf2f(hi[e])); }
            const u32x4 hw = {hi[0] | (hi[1] << 16), hi[2] | (hi[3] << 16), hi[4] | (hi[5] << 16), hi[6] | (hi[7] << 16)};
            const u32x4 lw = {lo[0] | (lo[1] << 16), lo[2] | (lo[3] << 16), lo[4] | (lo[5] << 16), lo[6] | (lo[7] << 16)};
            *(GAS u32x4*)(H2 + (size_t)(tb + 16 * mt + row) * D + k0) = hw;
            const bf16x8 ah = __builtin_bit_cast(bf16x8, hw), al = __builtin_bit_cast(bf16x8, lw);
#pragma unroll
            for (int nt = 0; nt < 5; ++nt) { acc[mt][nt] = __builtin_amdgcn_mfma_f32_16x16x32_bf16(ah, bh[nt], acc[mt][nt], 0, 0, 0);
                acc[mt][nt] = __builtin_amdgcn_mfma_f32_16x16x32_bf16(al, bh[nt], acc[mt][nt], 0, 0, 0);
                acc[mt][nt] = __builtin_amdgcn_mfma_f32_16x16x32_bf16(ah, bl[nt], acc[mt][nt], 0, 0, 0); } } }
#define RT_IDX(w4, mt, nt, r) ((((w4) * 64 + 16 * (mt) + 4 * q + (r)) * 80) + 16 * (nt) + row)
    if (wave >= 4) {
#pragma unroll
        for (int mt = 0; mt < 4; ++mt)
#pragma unroll
            for (int nt = 0; nt < 5; ++nt)
#pragma unroll
                for (int r = 0; r < 4; ++r) part[RT_IDX(wave - 4, mt, nt, r)] = acc[mt][nt][r]; }
    __syncthreads();
    if (wave < 4) {
#pragma unroll
        for (int mt = 0; mt < 4; ++mt)
#pragma unroll
            for (int nt = 0; nt < 5; ++nt)
#pragma unroll
                for (int r = 0; r < 4; ++r) acc[mt][nt][r] += part[RT_IDX(wave, mt, nt, r)]; }
    __syncthreads();
    if (wave < 4) {
#pragma unroll
        for (int mt = 0; mt < 4; ++mt)
#pragma unroll
            for (int nt = 0; nt < 5; ++nt)
#pragma unroll
                for (int r = 0; r < 4; ++r) part[RT_IDX(wave, mt, nt, r)] = acc[mt][nt][r]; }
#undef RT_IDX
    __syncthreads();
    if (wave == 0) { const int t = tb + lane; const LAS float* l0 = part + lane * 80;
        float gl[8]; int gs = 0; float gm = -3.0e38f;
#pragma unroll
        for (int i = 0; i < 8; ++i) { gl[i] = ((l0[i] + l0[5120 + i]) + (l0[10240 + i] + l0[15360 + i])) + A.in[28][i]; if (gl[i] > gm) { gm = gl[i]; gs = i; } }
        float gsum = 0.f;
#pragma unroll
        for (int i = 0; i < 8; ++i) gsum += __expf(gl[i] - gm);
        const float gw = 1.0f / gsum;
        float e0v = -3.0e38f, e1v = -3.0e38f; int i0 = 0, i1 = 0;
#pragma unroll
        for (int i = 0; i < 8; ++i) { const int o = 8 + gs * 8 + i; const float v = ((l0[o] + l0[5120 + o]) + (l0[10240 + o] + l0[15360 + o])) + A.in[30][gs * 8 + i];
            if (v > e0v) { e1v = e0v; i1 = i0; e0v = v; i0 = i; } else if (v > e1v) { e1v = v; i1 = i; } }
        const float x = __expf(e1v - e0v); const float c0 = gw / (1.f + x), c1 = gw * x / (1.f + x);
        const int e0 = gs * 8 + i0, e1 = gs * 8 + i1;
        const int p0 = (int)__hip_atomic_fetch_add(CNT + 64 * e0, 1u, RLX_AGENT), p1 = (int)__hip_atomic_fetch_add(CNT + 64 * e1, 1u, RLX_AGENT);
        LIST[(size_t)e0 * T + p0] = t; LIST[(size_t)e1 * T + p1] = t;
        ROUTE[4 * t + 0] = e0; ROUTE[4 * t + 1] = p0; ROUTE[4 * t + 2] = e1; ROUTE[4 * t + 3] = p1; COMB[2 * t] = c0; COMB[2 * t + 1] = c1; }
    __syncthreads();
}

__device__ __forceinline__ void moe_build_table(Frame& F) {
    volatile LAS int* tab = (volatile LAS int*)(F.lds + MOE_OFF);
    if (F.tid < NEXP) tab[F.tid] = (int)__hip_atomic_load((unsigned*)(F.ctl + CW_CNT) + 64 * F.tid, RLX_AGENT);
    __syncthreads();
    if (F.tid == 0) { int run = 0;
        for (int e = 0; e < NEXP; ++e) { tab[64 + e] = run; run += (tab[e] + 255) >> 8; }
        tab[128] = run; tab[129] = run;
        const int U = run * 4; int e = 0;
        for (int i = 0; i < pg8::MOE_MAXU; ++i) { const int L = i * F.G + (int)blockIdx.x;
            if (L < U) { const int q = U / 8, r = U % 8, xcd = L % 8, off = L / 8; const int id = (xcd < r ? xcd * (q + 1) : r * (q + 1) + (xcd - r) * q) + off;
                const int gt = id >> 2, pn = id & 3; e = 0; while (e < NEXP - 1 && tab[64 + e + 1] <= gt) ++e;
                tab[136 + 4 * i] = e; tab[136 + 4 * i + 1] = gt; tab[136 + 4 * i + 2] = pn; tab[136 + 4 * i + 3] = gt - tab[64 + e]; }
            else tab[136 + 4 * i] = -1; } }
    __syncthreads();
}
__device__ __forceinline__ void final_rows(Frame& F, const Args& A, int gw, int NGW) {
    volatile LAS int* tab = (volatile LAS int*)(F.lds + MOE_OFF);
    const int* ROUTE = (const int*)(F.ws + WS_ROUTE); const float* COMB = (const float*)(F.ws + WS_ROUTE + 512 * 1024); const bf16* YM = (const bf16*)(F.ws + WS_YMOE);
    for (int t = gw; t < T; t += NGW) {
        const int e0 = ROUTE[4 * t], p0 = ROUTE[4 * t + 1], e1 = ROUTE[4 * t + 2], p1 = ROUTE[4 * t + 3]; const float c0 = COMB[2 * t], c1 = COMB[2 * t + 1];
        const size_t r0 = (size_t)tab[64 + e0] * 256 + p0, r1 = (size_t)tab[64 + e1] * 256 + p1;
        GAS f32x4* xr = (GAS f32x4*)(F.out + (size_t)t * D) + F.lane; const GAS u32x2* y0 = (const GAS u32x2*)(YM + r0 * D) + F.lane; const GAS u32x2* y1 = (const GAS u32x2*)(YM + r1 * D) + F.lane;
        f32x4 v[4]; float s = 0.f;
#pragma unroll
        for (int j = 0; j < 4; ++j) { v[j] = xr[64 * j]; const u32x2 a = y0[64 * j], b = y1[64 * j];
            v[j].x += c0 * bflo(a.x) + c1 * bflo(b.x); v[j].y += c0 * bfhi(a.x) + c1 * bfhi(b.x); v[j].z += c0 * bflo(a.y) + c1 * bflo(b.y); v[j].w += c0 * bfhi(a.y) + c1 * bfhi(b.y);
            s += (v[j].x * v[j].x + v[j].y * v[j].y) + (v[j].z * v[j].z + v[j].w * v[j].w); }
        const float rinv = 1.0f / sqrtf(wave_sum(s) * (1.f / D) + NORM_EPS);
        const GAS f32x4* gr = (const GAS f32x4*)A.in[34] + F.lane;
#pragma unroll
        for (int j = 0; j < 4; ++j) xr[64 * j] = v[j] * rinv * gr[64 * j];
    }
}

constexpr int N_PHASES = 11;
__global__ void __launch_bounds__(NWAVES * 64, 2) mk_fwd(Args args) {
    extern __shared__ __attribute__((aligned(16))) unsigned char lds[];
    Frame F;
    F.lds = (LAS unsigned char*)lds;
    F.MISC = (volatile LAS unsigned*)(F.lds + MISC_OFF);
    F.tid = threadIdx.x; F.lane = F.tid & 63; F.wave = __builtin_amdgcn_readfirstlane(F.tid >> 6);
    F.G = gridDim.x; { const int bx = blockIdx.x; F.vcu = (F.G % 8 == 0) ? (bx % 8) * (F.G / 8) + bx / 8 : bx; }
    unsigned char* ws = args.ws; F.ws = ws; F.out = args.out;
    F.ctl = (gu32*)(ws + WS_CTL);
    for (int u = F.tid; u < (LDS_BYTES - LDSCTL_OFF) / 4; u += NWAVES * 64) ((LAS unsigned*)(F.lds + LDSCTL_OFF))[u] = 0u;
    __syncthreads();
#if MK_MULTI
#define GRID_BAR() do { } while (0)
#else
    XcdBarrier bar = xcd_barrier_post((unsigned*)(F.ctl + CW_BAR), F.MISC + 8);
#define GRID_BAR() xcd_barrier(bar)
#endif
    const int lo = args.ph_lo, hi = args.ph_hi;
#define IN(k) (lo <= (k) && (k) < hi)
#define BOTH(k) (IN(k) && IN((k) + 1))
    const int gw = F.vcu * NWAVES + F.wave, NGW = F.G * NWAVES;
    const char* wsc = (const char*)ws;

    if (IN(0)) { p0_prologue(F, args); if (BOTH(0)) GRID_BAR(); }
    if (IN(1)) {
        pg8::SchedP1 S{F.G, (int)blockIdx.x, wsc + WS_H, wsc + WS_MEMN, wsc + WS_WIN, wsc + WS_WKV, false};
        pg8::EpiP E{(bf16*)(ws + WS_P), (bf16*)(ws + WS_KB), (bf16*)(ws + WS_VT)};
        pg8::gemm_phase<pg8::EpiP, pg8::SchedP1, false>(F.lds, S, E);
        if (BOTH(1)) GRID_BAR();
    }
    if (IN(2)) {
        for (int j = blockIdx.x; j < T / 64; j += F.G) { rwkv_chunk_job(F, args, j); conv_job(F, args, j); }
        if (BOTH(2)) GRID_BAR();
    }
    if (IN(3)) {
        if (F.G >= 64) {
            if (blockIdx.x < NB * NHEAD) rwkv_chain_wg(F, (int)blockIdx.x);
            else {
                if (blockIdx.x < NB * NHEAD + 8) {
                    pg8::SchedP1 S{F.G, (int)blockIdx.x - NB * NHEAD, wsc + WS_H, wsc + WS_MEMN, wsc + WS_WIN, wsc + WS_WKV, true};
                    pg8::EpiP E{(bf16*)(ws + WS_P), (bf16*)(ws + WS_KB), (bf16*)(ws + WS_VT)};
                    pg8::gemm_phase<pg8::EpiP, pg8::SchedP1, false>(F.lds, S, E);
                }
                else convert_experts(F, args, ((int)blockIdx.x - NB * NHEAD - 8) * NWAVES + F.wave, (F.G - NB * NHEAD - 8) * NWAVES);
            }
        } else {
            { pg8::SchedP1 S{F.G, (int)blockIdx.x, wsc + WS_H, wsc + WS_MEMN, wsc + WS_WIN, wsc + WS_WKV, true};
              pg8::EpiP E{(bf16*)(ws + WS_P), (bf16*)(ws + WS_KB), (bf16*)(ws + WS_VT)};
              pg8::gemm_phase<pg8::EpiP, pg8::SchedP1, false>(F.lds, S, E); }
            if (blockIdx.x < NB * NHEAD && F.G >= NB * NHEAD) rwkv_chain_wg(F, (int)blockIdx.x);
            convert_experts(F, args, gw, NGW);
        }
        if (BOTH(3)) GRID_BAR();
    }
    if (IN(4)) { for (int ci = gw; ci < (T / 64) * NHEAD; ci += NGW) rwkv_out(F, args, ci); for (int u = blockIdx.x; u < 256; u += F.G) mem_attn_unit(F, u); if (BOTH(4)) GRID_BAR(); }
    if (IN(5)) {
        pg8::SchedMerge S{F.G, (int)blockIdx.x, wsc + WS_H, wsc + WS_YB, wsc + WS_WGATE, wsc + WS_WBR};
        pg8::EpiMerge E{args.in[24], (bf16*)(ws + WS_GS) + (size_t)blockIdx.x * 65536, (bf16*)(ws + WS_Z)};
        pg8::gemm_phase<pg8::EpiMerge, pg8::SchedMerge, false>(F.lds, S, E);
        if (BOTH(5)) GRID_BAR();
    }
    if (IN(6)) {
        pg8::SchedX2 S{F.G, (int)blockIdx.x, wsc + WS_Z, wsc + WS_WO};
        pg8::EpiX2 E{args.in[0], F.out};
        pg8::gemm_phase<pg8::EpiX2, pg8::SchedX2, false>(F.lds, S, E);
        if (BOTH(6)) GRID_BAR();
    }
    if (IN(7)) { for (int j = blockIdx.x; j < T / 64; j += F.G) router_job(F, args, j); if (BOTH(7)) GRID_BAR(); }
    if (IN(8)) {
        moe_build_table(F);
        pg8::SchedMoe S{(const volatile LAS int*)(F.lds + MOE_OFF), 1, wsc + WS_H, wsc + WS_HID, wsc + WS_E1, wsc + WS_E2, (const int*)(ws + WS_LIST)};
        pg8::EpiHid E{(bf16*)(ws + WS_HID)};
        pg8::gemm_phase<pg8::EpiHid, pg8::SchedMoe, true>(F.lds, S, E);
        if (BOTH(8)) GRID_BAR();
    }
    if (IN(9)) {
        moe_build_table(F);
        pg8::SchedMoe S{(const volatile LAS int*)(F.lds + MOE_OFF), 2, wsc + WS_H, wsc + WS_HID, wsc + WS_E1, wsc + WS_E2, (const int*)(ws + WS_LIST)};
        pg8::EpiY E{(bf16*)(ws + WS_YMOE)};
        pg8::gemm_phase<pg8::EpiY, pg8::SchedMoe, false>(F.lds, S, E);
        if (BOTH(9)) GRID_BAR();
    }
    if (IN(10)) { moe_build_table(F); final_rows(F, args, gw, NGW); }
#undef IN
#undef BOTH
}

extern "C" void kernel_launch(void* const* d_in, const int* in_sizes, int n_in, void* d_out, int out_size, void* d_ws, size_t ws_size, hipStream_t stream) {
    static int grid = 0;
    if (grid == 0) {
        if (n_in != 35 || in_sizes[0] != T * D || out_size != T * D || ws_size < WS_END) { fprintf(stderr, "kernel_launch: unexpected shapes / workspace (n_in %d, in0 %d, out %d, ws %zu)\n", n_in, n_in > 0 ? in_sizes[0] : -1, out_size, ws_size); grid = -1; return; }
        int dev = 0, cus = 0, per_cu = 0;
        if (hipGetDevice(&dev) != hipSuccess || hipDeviceGetAttribute(&cus, hipDeviceAttributeMultiprocessorCount, dev) != hipSuccess) { grid = -1; return; }
        if (hipFuncSetAttribute((const void*)mk_fwd, hipFuncAttributeMaxDynamicSharedMemorySize, LDS_BYTES) != hipSuccess) { fprintf(stderr, "kernel_launch: hipFuncSetAttribute failed\n"); grid = -1; return; }
        if (hipOccupancyMaxActiveBlocksPerMultiprocessor(&per_cu, (const void*)mk_fwd, NWAVES * 64, LDS_BYTES) != hipSuccess || per_cu < 1) fprintf(stderr, "kernel_launch: occupancy query reports %d\n", per_cu);
        (void)hipGetLastError();
        grid = cus;
    }
    if (grid < 0) return;
    if (hipMemsetAsync((char*)d_ws + WS_CTL, 0, CTL_ZERO_BYTES, stream) != hipSuccess) { fprintf(stderr, "kernel_launch: memset failed\n"); return; }
    Args a{};
    for (int i = 0; i < 35; ++i) a.in[i] = (const float*)d_in[i];
    a.out = (float*)d_out; a.ws = (unsigned char*)d_ws;
#if MK_MULTI
    for (int p = 0; p < N_PHASES; ++p) { a.ph_lo = p; a.ph_hi = p + 1; hipLaunchKernelGGL(mk_fwd, dim3(grid), dim3(NWAVES * 64), LDS_BYTES, stream, a); }
#else
    a.ph_lo = 0; a.ph_hi = N_PHASES; hipLaunchKernelGGL(mk_fwd, dim3(grid), dim3(NWAVES * 64), LDS_BYTES, stream, a);
#endif
    const hipError_t le = hipPeekAtLastError();
    if (le != hipSuccess) fprintf(stderr, "kernel_launch: launch failed: %s\n", hipGetErrorName(le));
}
```
